# Optimizing an MI355X kernel written in HIP

```python
import jax, jax.numpy as jnp
from jax import lax
import numpy as np

D_MODEL = 1024
BATCH = 8
SEQ = 4096
DEPTH = 1

N_META = 16
BLOCK = 128
HEAD_DIM = 64
ROPE_THETA = 10000.0
EPS = 1e-6
NEG_INF = -1e30
SA_HEADS = 8
SA_KV_HEADS = 1
TOPK_MAX = 256
IDX_HEADS = 4
IDX_DIM = 64
SW_HEADS = 8
SW_KV_HEADS = 2
WINDOW = 128
D_FF = 2816

IN_SIZES = (
    SA_HEADS * HEAD_DIM,
    SA_KV_HEADS * HEAD_DIM,
    SA_KV_HEADS * HEAD_DIM,
    IDX_HEADS * IDX_DIM,
    IDX_DIM,
    IDX_HEADS,
    SW_HEADS * HEAD_DIM,
    SW_KV_HEADS * HEAD_DIM,
    SW_KV_HEADS * HEAD_DIM,
    D_MODEL,
    D_MODEL,
)
IN_WIDTH = int(sum(IN_SIZES))
IN_SPLITS = tuple(int(v) for v in np.cumsum(IN_SIZES)[:-1])

kernel_name = "hybrid_dsa_swa_sink_macaron_meta"


def rmsnorm(x, g):
    xf = x.astype(jnp.float32)
    y = xf * lax.rsqrt(jnp.mean(xf * xf, axis=-1, keepdims=True) + EPS)
    return (y * g.astype(jnp.float32)).astype(x.dtype)


def rope(x, pos):
    d = x.shape[-1]
    inv_freq = 1.0 / (ROPE_THETA ** (jnp.arange(0, d, 2, dtype=jnp.float32) / d))
    ang = pos.astype(jnp.float32)[:, None] * inv_freq[None, :]
    cos = jnp.cos(ang)[None, :, None, :].astype(x.dtype)
    sin = jnp.sin(ang)[None, :, None, :].astype(x.dtype)
    x1, x2 = x[..., : d // 2], x[..., d // 2:]
    return jnp.concatenate([x1 * cos - x2 * sin, x2 * cos + x1 * sin], axis=-1)


def swiglu(x, w_gate, w_up, w_down):
    return (jax.nn.silu(x @ w_gate) * (x @ w_up)) @ w_down


def sparse_branch(qa, ka, va, qi, ki, wi, pos, kvalid, topk):
    B, N = qa.shape[0], qa.shape[1]
    NC = N // BLOCK
    scale = HEAD_DIM ** -0.5

    def to_blocks(t):
        return jnp.moveaxis(t.reshape((B, NC, BLOCK) + t.shape[2:]), 1, 0)

    def one_block(args):
        qa_b, qi_b, wi_b, qpos = args
        rel = jax.nn.relu(jnp.einsum('bqhd,bsd->bqhs', qi_b, ki).astype(jnp.float32))
        score = jnp.einsum('bqhs,bqh->bqs', rel, wi_b.astype(jnp.float32))
        admissible = kvalid[None, :] & (pos[None, :] <= qpos[:, None])
        score = jnp.where(admissible[None], score, NEG_INF)
        top_val, top_idx = lax.top_k(score, topk)
        sel_ok = top_val > 0.5 * NEG_INF
        k_sel = jax.vmap(lambda a, i: a[i])(ka, top_idx)
        v_sel = jax.vmap(lambda a, i: a[i])(va, top_idx)
        s = jnp.einsum('bqhd,bqkd->bqhk', qa_b, k_sel).astype(jnp.float32) * scale
        s = jnp.where(sel_ok[:, :, None, :], s, NEG_INF)
        p = jax.nn.softmax(s, axis=-1).astype(va.dtype)
        o = jnp.einsum('bqhk,bqkd->bqhd', p, v_sel)
        return o.reshape(B, BLOCK, SA_HEADS * HEAD_DIM)

    out = lax.map(one_block, (to_blocks(qa), to_blocks(qi), to_blocks(wi), pos.reshape(NC, BLOCK)))
    return jnp.moveaxis(out, 0, 1).reshape(B, N, SA_HEADS * HEAD_DIM)


def swa_branch(qs, ks, vs, sinks, pos, kvalid):
    B, N = qs.shape[0], qs.shape[1]
    NC = N // BLOCK
    G = SW_HEADS // SW_KV_HEADS
    scale = HEAD_DIM ** -0.5
    q = qs.reshape(B, NC, BLOCK, SW_KV_HEADS, G, HEAD_DIM)
    k = ks.reshape(B, NC, BLOCK, SW_KV_HEADS, HEAD_DIM)
    v = vs.reshape(B, NC, BLOCK, SW_KV_HEADS, HEAD_DIM)
    shift = lambda t: jnp.concatenate([jnp.zeros_like(t[:, :1]), t[:, :-1]], axis=1)
    kb = jnp.concatenate([shift(k), k], axis=2)
    vb = jnp.concatenate([shift(v), v], axis=2)
    pos_c = pos.reshape(NC, BLOCK)
    val_c = kvalid.reshape(NC, BLOCK)
    prev_pos = jnp.concatenate([jnp.full((1, BLOCK), -1, pos.dtype), pos_c[:-1]], axis=0)
    prev_val = jnp.concatenate([jnp.zeros((1, BLOCK), bool), val_c[:-1]], axis=0)
    kpos = jnp.concatenate([prev_pos, pos_c], axis=1)
    kval = jnp.concatenate([prev_val, val_c], axis=1)
    diff = pos_c[:, :, None] - kpos[:, None, :]
    mask = kval[:, None, :] & (diff >= 0) & (diff < WINDOW)
    s = jnp.einsum('bcqkgd,bcskd->bckgqs', q, kb).astype(jnp.float32) * scale
    s = jnp.where(mask[None, :, None, None], s, NEG_INF)
    sink = sinks.astype(jnp.float32).reshape(1, 1, SW_KV_HEADS, G, 1, 1)
    m = jnp.maximum(jnp.max(s, axis=-1, keepdims=True), sink)
    e = jnp.exp(s - m)
    p = e / (jnp.sum(e, axis=-1, keepdims=True) + jnp.exp(sink - m))
    o = jnp.einsum('bckgqs,bcskd->bcqkgd', p.astype(vs.dtype), vb)
    return o.reshape(B, N, SW_HEADS * HEAD_DIM)


def setup_inputs(seed: int = 0) -> dict:
    key = jax.random.key(seed)
    ks = jax.random.split(key, 20)
    f32 = jnp.float32
    nrm = lambda k, shape, fan_in: jax.random.normal(k, shape, f32) * (fan_in ** -0.5)
    gain = lambda k, shape: 1.0 + 0.01 * jax.random.normal(k, shape, f32)
    L = DEPTH
    return {
        "x": jax.random.normal(ks[0], (BATCH, SEQ, D_MODEL), f32),
        "meta_tokens": jax.random.normal(ks[1], (N_META, D_MODEL), f32),
        "norm_ffn1": gain(ks[2], (L, D_MODEL)),
        "w_ffn1_gate": nrm(ks[3], (L, D_MODEL, D_FF), D_MODEL),
        "w_ffn1_up": nrm(ks[4], (L, D_MODEL, D_FF), D_MODEL),
        "w_ffn1_down": nrm(ks[5], (L, D_FF, D_MODEL), D_FF),
        "norm_mix": gain(ks[6], (L, D_MODEL)),
        "w_in": nrm(ks[7], (L, D_MODEL, IN_WIDTH), D_MODEL),
        "sinks": 0.5 * jax.random.normal(ks[8], (L, SW_HEADS), f32),
        "w_branch_sparse": nrm(ks[9], (L, SA_HEADS * HEAD_DIM, D_MODEL), SA_HEADS * HEAD_DIM),
        "w_branch_swa": nrm(ks[10], (L, SW_HEADS * HEAD_DIM, D_MODEL), SW_HEADS * HEAD_DIM),
        "w_out": nrm(ks[11], (L, D_MODEL, D_MODEL), D_MODEL),
        "norm_ffn2": gain(ks[12], (L, D_MODEL)),
        "w_ffn2_gate": nrm(ks[13], (L, D_MODEL, D_FF), D_MODEL),
        "w_ffn2_up": nrm(ks[14], (L, D_MODEL, D_FF), D_MODEL),
        "w_ffn2_down": nrm(ks[15], (L, D_FF, D_MODEL), D_FF),
        "norm_final": gain(ks[16], (D_MODEL,)),
    }


def reference(x, meta_tokens, norm_ffn1, w_ffn1_gate, w_ffn1_up, w_ffn1_down, norm_mix, w_in, sinks,
              w_branch_sparse, w_branch_swa, w_out, norm_ffn2, w_ffn2_gate, w_ffn2_up, w_ffn2_down, norm_final):
    B, S, D = x.shape
    topk = min(TOPK_MAX, S // 4)
    n_pad = BLOCK - N_META
    h = jnp.concatenate([
        jnp.zeros((B, n_pad, D), x.dtype),
        jnp.broadcast_to(meta_tokens.astype(x.dtype)[None], (B, N_META, D)),
        x,
    ], axis=1)
    N = h.shape[1]
    pos = jnp.arange(N, dtype=jnp.int32) - n_pad
    kvalid = pos >= 0
    rpos = jnp.maximum(pos, 0)
    idx_scale = (IDX_HEADS ** -0.5) * (IDX_DIM ** -0.5)

    for l in range(DEPTH):
        h = h + 0.5 * swiglu(rmsnorm(h, norm_ffn1[l]), w_ffn1_gate[l], w_ffn1_up[l], w_ffn1_down[l])

        u = rmsnorm(h, norm_mix[l])
        qa, ka, va, qi, ki, wi, qs, ksw, vsw, ga, gb = jnp.split(u @ w_in[l], IN_SPLITS, axis=-1)
        qa = rope(qa.reshape(B, N, SA_HEADS, HEAD_DIM), rpos)
        ka = rope(ka.reshape(B, N, SA_KV_HEADS, HEAD_DIM), rpos)[:, :, 0]
        va = va.reshape(B, N, HEAD_DIM)
        qi = rope(qi.reshape(B, N, IDX_HEADS, IDX_DIM), rpos)
        ki = rope(ki.reshape(B, N, 1, IDX_DIM), rpos)[:, :, 0]
        wi = wi * idx_scale
        qs = rope(qs.reshape(B, N, SW_HEADS, HEAD_DIM), rpos)
        ksw = rope(ksw.reshape(B, N, SW_KV_HEADS, HEAD_DIM), rpos)
        vsw = vsw.reshape(B, N, SW_KV_HEADS, HEAD_DIM)

        o_sparse = sparse_branch(qa, ka, va, qi, ki, wi, pos, kvalid, topk)
        o_swa = swa_branch(qs, ksw, vsw, sinks[l], pos, kvalid)

        merged = (jax.nn.sigmoid(ga) * (o_sparse @ w_branch_sparse[l])
                  + jax.nn.sigmoid(gb) * (o_swa @ w_branch_swa[l]))
        h = h + merged @ w_out[l]

        h = h + 0.5 * swiglu(rmsnorm(h, norm_ffn2[l]), w_ffn2_gate[l], w_ffn2_up[l], w_ffn2_down[l])

    return rmsnorm(h[:, BLOCK:], norm_final)
```

```cpp
#include <hip/hip_runtime.h>
#include <cstdio>
#include <cstdint>
#include <cmath>

#ifndef MK_N_LAUNCHES
#define MK_N_LAUNCHES 1
#endif

namespace pg8 {
#define PG8_LAS __attribute__((address_space(3)))
typedef unsigned short bf16_t;
typedef short bf16x8 __attribute__((ext_vector_type(8)));
typedef float f32x4 __attribute__((ext_vector_type(4)));
typedef unsigned u32x4 __attribute__((ext_vector_type(4)));
typedef unsigned u32x2 __attribute__((ext_vector_type(2)));
constexpr int BM = 256, BK = 64, HALF = 128, HTB = HALF * BK * 2  , STAGE_BYTES = 8 * HTB, NXCD = 8, WGM = 8;

__host__ __device__ __forceinline__ int lds_byte(int r, int c) { const int st = (r >> 4) * 2 + (c >> 5), rr = r & 15, cc = c & 31, ob = rr * 64 + cc * 2; return st * 1024 + (ob ^ (((ob >> 9) & 1) << 5)); }
__host__ __device__ __forceinline__ void stage_rc(int b, int& R, int& C) { const int st = b / 1024, sb = b % 1024, swz = sb ^ (((sb >> 9) & 1) << 5); R = (st >> 1) * 16 + swz / 64; C = (st & 1) * 32 + (swz % 64) / 2; }
__host__ __device__ __forceinline__ int perm32(int rho) { const int n = rho >> 4, i = rho & 15; return 8 * (i >> 2) + 4 * n + (i & 3); }

struct Unit { int pm, pn; };
struct Gemm { const bf16_t* A; const bf16_t* Bt; int M, N, K; };

struct StaticOrder {
    int nM, nN, nwg, G, c;
    __host__ __device__ void init(int M, int N, int G_, int c_) { nM = M / BM; nN = N / BM; nwg = nM * nN; G = G_; c = c_; }
    __host__ __device__ bool next(int i, Unit& u) const {
        const long L = (long)i * G + c; if (L >= nwg) return false;
        int wgid = (int)L; { const int q = nwg / NXCD, r = nwg % NXCD, xcd = wgid % NXCD, off = wgid / NXCD; wgid = (xcd < r ? xcd * (q + 1) : r * (q + 1) + (xcd - r) * q) + off; }
        const int nig = WGM * nN, gid = wgid / nig, fm = gid * WGM, gsz = (nM - fm) < WGM ? (nM - fm) : WGM;
        u.pm = fm + ((wgid % nig) % gsz); u.pn = (wgid % nig) / gsz; return true;
    }
    __device__ __forceinline__ void a_ready(const Unit&) const {}
    __device__ __forceinline__ void done(const Unit&) const {}
};
struct ListOrder {
    int n, c, pn0, pn1;
    __device__ bool next(int i, Unit& u) const { if (i != 0 || c >= n) return false; u.pm = 0; u.pn = (pn1 >= 0) ? (c == 0 ? pn0 : pn1) : (pn0 + c); return true; }
    __device__ __forceinline__ void a_ready(const Unit&) const {}
    __device__ __forceinline__ void done(const Unit&) const {}
};

__device__ __forceinline__ unsigned cvt_pk_bf16(float lo, float hi) { unsigned r; asm volatile("v_cvt_pk_bf16_f32 %0, %1, %2" : "=v"(r) : "v"(lo), "v"(hi)); return r; }
template <class Epi, class Sched, bool ALIGN_EPI = false, bool SP2 = false>
__device__ __forceinline__ void gemm_phase(PG8_LAS unsigned char* lds, const Gemm g, const Sched& S, const Epi& E) {
    const int tid = threadIdx.x, wid = __builtin_amdgcn_readfirstlane(tid >> 6), lane = tid & 63, wr = wid >> 2, wc = wid & 3, fr = lane & 15, fq = lane >> 4;
    const int K = g.K, nt = K / BK;
    unsigned voffA[2], voffB[2];
#pragma unroll
    for (int i = 0; i < 2; ++i) { int R, C; stage_rc(tid * 16 + i * 8192, R, C); const int Rb = Epi::PERM ? ((R & ~31) + perm32(R & 31)) : R;
        voffA[i] = (unsigned)(R * K + C) * 2u; voffB[i] = (unsigned)(Rb * K + C) * 2u; }
    const size_t kstep = (size_t)(BK * 2);
    const size_t hstep = (size_t)HALF * K * 2;
    const size_t tstep = 2 * hstep;
    const unsigned ldsw = (unsigned)wid * 1024u;
    const int aoff = lds_byte(wr * 64 + fr, fq * 8), boff = lds_byte(wc * 32 + fr, fq * 8);
#define PG8_SA(b, h) (((b) * 2 + (h)) * HTB)
#define PG8_SB(b, h) ((4 + (b) * 2 + (h)) * HTB)
#define PG8_STAGE(bufoff, gbase, voff) do { _Pragma("unroll") for (int _i = 0; _i < 2; ++_i) \
        __builtin_amdgcn_global_load_lds((const unsigned*)((const char*)(gbase) + (voff)[_i]), (PG8_LAS unsigned*)(lds + (bufoff) + ldsw + _i * 8192), 16, 0, 0); } while (0)
#define PG8_LDA(dst, b, h) do { _Pragma("unroll") for (int m = 0; m < 4; ++m) _Pragma("unroll") for (int k = 0; k < 2; ++k) dst[m][k] = *(const PG8_LAS bf16x8*)(lds + PG8_SA(b, h) + aoff + m * 2048 + k * 1024); } while (0)
#define PG8_LDB(dst, b, h) do { _Pragma("unroll") for (int n = 0; n < 2; ++n) _Pragma("unroll") for (int k = 0; k < 2; ++k) dst[n][k] = *(const PG8_LAS bf16x8*)(lds + PG8_SB(b, h) + boff + n * 2048 + k * 1024); } while (0)
#define PG8_MMA(ai, bj, At, Bt) do { __builtin_amdgcn_s_setprio(1); _Pragma("unroll") for (int m = 0; m < 4; ++m) _Pragma("unroll") for (int n = 0; n < 2; ++n) _Pragma("unroll") for (int k = 0; k < 2; ++k) \
        acc[ai][bj][m][n] = __builtin_amdgcn_mfma_f32_16x16x32_bf16(Bt[n][k], At[m][k], acc[ai][bj][m][n], 0, 0, 0); __builtin_amdgcn_s_setprio(0); } while (0)
#define PG8_WAIT_V(n) asm volatile("s_waitcnt vmcnt(" #n ")" ::: "memory")
#define PG8_WAIT_L(n) asm volatile("s_waitcnt lgkmcnt(" #n ")" ::: "memory")
#define PG8_BAR __builtin_amdgcn_s_barrier()
#define PG8_SCHED __builtin_amdgcn_sched_barrier(0)
    Unit cur, nxt; int ui = 0;
    if (!S.next(0, cur)) return;
    f32x4 acc[2][2][4][2];
#pragma unroll
    for (int a = 0; a < 2; ++a)
#pragma unroll
        for (int b = 0; b < 2; ++b)
#pragma unroll
            for (int m = 0; m < 4; ++m)
#pragma unroll
                for (int n = 0; n < 2; ++n) acc[a][b][m][n] = (f32x4){0.f, 0.f, 0.f, 0.f};
    bf16x8 At[4][2], B0[2][2], B1[2][2];
    const char* cA = (const char*)g.A + (size_t)cur.pm * tstep; const char* cB = (const char*)g.Bt + (size_t)cur.pn * tstep;
    S.a_ready(cur);
    if constexpr (SP2) {
        PG8_STAGE(PG8_SB(0, 0), cB, voffB); PG8_STAGE(PG8_SB(0, 1), cB + hstep, voffB); PG8_STAGE(PG8_SA(0, 0), cA, voffA); PG8_STAGE(PG8_SA(0, 1), cA + hstep, voffA);
        if (wr == 1) PG8_BAR;
        PG8_WAIT_V(2); PG8_BAR;
        PG8_STAGE(PG8_SB(1, 0), cB + kstep, voffB); PG8_STAGE(PG8_SA(1, 0), cA + kstep, voffA); PG8_STAGE(PG8_SB(1, 1), cB + hstep + kstep, voffB);
        PG8_WAIT_V(6); PG8_BAR;
    } else {
        PG8_STAGE(PG8_SB(0, 0), cB, voffB); PG8_STAGE(PG8_SA(0, 0), cA, voffA); PG8_STAGE(PG8_SB(0, 1), cB + hstep, voffB); PG8_STAGE(PG8_SA(0, 1), cA + hstep, voffA);
        if (wr == 1) PG8_BAR;
        PG8_WAIT_V(4); PG8_BAR;
        PG8_STAGE(PG8_SB(1, 0), cB + kstep, voffB); PG8_STAGE(PG8_SA(1, 0), cA + kstep, voffA); PG8_STAGE(PG8_SB(1, 1), cB + hstep + kstep, voffB);
        PG8_WAIT_V(6); PG8_BAR;
    }
    for (;;) {
        const bool has_next = S.next(ui + 1, nxt);
        const char* nA = has_next ? (const char*)g.A + (size_t)nxt.pm * tstep : cA; const char* nB = has_next ? (const char*)g.Bt + (size_t)nxt.pn * tstep : cB;
        for (int t = 0; t < nt; t += 2) {
            const bool last = (t == nt - 2);
            const char* a1 = cA + (size_t)(t + 1) * kstep;
            const char* a2 = last ? nA : cA + (size_t)(t + 2) * kstep; const char* b2 = last ? nB : cB + (size_t)(t + 2) * kstep;
            const char* a3 = a2 + kstep; const char* b3 = b2 + kstep;
            if (last && has_next) S.a_ready(nxt);
            if constexpr (SP2) {
            PG8_LDB(B0, 0, 0); PG8_LDB(B1, 0, 1); PG8_SCHED; PG8_LDA(At, 0, 0); PG8_STAGE(PG8_SA(1, 1), a1 + hstep, voffA);
            PG8_WAIT_V(8); PG8_WAIT_L(0); PG8_BAR; PG8_MMA(0, 0, At, B0); PG8_MMA(0, 1, At, B1); PG8_BAR; PG8_SCHED;
            PG8_LDA(At, 0, 1); PG8_STAGE(PG8_SB(0, 0), b2, voffB); PG8_STAGE(PG8_SB(0, 1), b2 + hstep, voffB); PG8_STAGE(PG8_SA(0, 0), a2, voffA);
            PG8_WAIT_V(8); PG8_WAIT_L(0); PG8_BAR; PG8_MMA(1, 0, At, B0); PG8_MMA(1, 1, At, B1); PG8_BAR; PG8_SCHED;
            PG8_LDB(B0, 1, 0); PG8_LDB(B1, 1, 1); PG8_SCHED; PG8_LDA(At, 1, 0); PG8_STAGE(PG8_SA(0, 1), a2 + hstep, voffA);
            PG8_WAIT_V(8); PG8_WAIT_L(0); PG8_BAR; PG8_MMA(0, 0, At, B0); PG8_MMA(0, 1, At, B1); PG8_BAR; PG8_SCHED;
            PG8_LDA(At, 1, 1); PG8_STAGE(PG8_SB(1, 0), b3, voffB); PG8_STAGE(PG8_SB(1, 1), b3 + hstep, voffB); PG8_STAGE(PG8_SA(1, 0), a3, voffA);
            PG8_WAIT_V(8); PG8_WAIT_L(0); PG8_BAR; PG8_MMA(1, 0, At, B0); PG8_MMA(1, 1, At, B1); PG8_BAR; PG8_SCHED;
            } else {
            PG8_LDB(B0, 0, 0); PG8_SCHED; PG8_LDA(At, 0, 0); PG8_STAGE(PG8_SA(1, 1), a1 + hstep, voffA);
            PG8_WAIT_L(8); PG8_BAR; PG8_WAIT_L(0); PG8_MMA(0, 0, At, B0); PG8_BAR; PG8_SCHED;
            PG8_LDB(B1, 0, 1); PG8_STAGE(PG8_SB(0, 0), b2, voffB);
            PG8_BAR; PG8_WAIT_L(0); PG8_MMA(0, 1, At, B1); PG8_BAR;
            PG8_LDA(At, 0, 1); PG8_STAGE(PG8_SA(0, 0), a2, voffA);
            PG8_BAR; PG8_WAIT_L(0); PG8_MMA(1, 0, At, B0); PG8_BAR; PG8_SCHED;
            PG8_STAGE(PG8_SB(0, 1), b2 + hstep, voffB);
            PG8_WAIT_V(6); PG8_BAR; PG8_MMA(1, 1, At, B1); PG8_BAR;
            PG8_LDB(B0, 1, 0); PG8_SCHED; PG8_LDA(At, 1, 0); PG8_STAGE(PG8_SA(0, 1), a2 + hstep, voffA);
            PG8_WAIT_L(8); PG8_BAR; PG8_WAIT_L(0); PG8_MMA(0, 0, At, B0); PG8_BAR; PG8_SCHED;
            PG8_LDB(B1, 1, 1); PG8_STAGE(PG8_SB(1, 0), b3, voffB);
            PG8_BAR; PG8_WAIT_L(0); PG8_MMA(0, 1, At, B1); PG8_BAR;
            PG8_LDA(At, 1, 1); PG8_STAGE(PG8_SA(1, 0), a3, voffA);
            PG8_BAR; PG8_WAIT_L(0); PG8_MMA(1, 0, At, B0); PG8_BAR; PG8_SCHED;
            PG8_STAGE(PG8_SB(1, 1), b3 + hstep, voffB);
            PG8_WAIT_V(6); PG8_BAR; PG8_MMA(1, 1, At, B1); PG8_BAR;
            }
        }
        if constexpr (ALIGN_EPI) { if (wr == 0) PG8_BAR; }
        if constexpr (!Epi::AFTER_DRAIN) { E(acc, cur, wr, wc, fr, fq); S.done(cur); }
        if (!has_next) break;
#pragma unroll
        for (int a = 0; a < 2; ++a)
#pragma unroll
            for (int b = 0; b < 2; ++b)
#pragma unroll
                for (int m = 0; m < 4; ++m)
#pragma unroll
                    for (int n = 0; n < 2; ++n) acc[a][b][m][n] = (f32x4){0.f, 0.f, 0.f, 0.f};
        cur = nxt; cA = nA; cB = nB; ++ui;
        if constexpr (ALIGN_EPI) { if (wr == 1) PG8_BAR; }
    }
    PG8_WAIT_V(0);
    if constexpr (!ALIGN_EPI) { if (wr == 0) PG8_BAR; }
    PG8_BAR;
    if constexpr (Epi::AFTER_DRAIN) { E.fused(acc, cur, wr, wc, fr, fq, lds, wid, lane); S.done(cur); }
#undef PG8_SA
#undef PG8_SB
#undef PG8_STAGE
#undef PG8_LDA
#undef PG8_LDB
#undef PG8_MMA
#undef PG8_WAIT_V
#undef PG8_WAIT_L
#undef PG8_BAR
#undef PG8_SCHED
}
}

constexpr int BATCH = 8, SEQ = 4096, DM = 1024, FF = 2816, NMETA = 16;
constexpr int MR = BATCH * SEQ;
constexpr int NKV = SEQ + 128;
constexpr int NIN = 3840;
constexpr float EPS = 1e-6f;
constexpr float LOG2E = 1.4426950408889634f;
constexpr float QSCALE = 0.125f * LOG2E;
constexpr float IDX_SCALE = 0.0625f;

namespace epi {
using pg8::f32x4; using pg8::u32x2; using pg8::Unit; using pg8::bf16_t; using pg8::cvt_pk_bf16;
typedef _Float16 f16x2 __attribute__((ext_vector_type(2)));

__device__ __forceinline__ float row_rs(const float* ssq, int row) {
    const f32x4* p = (const f32x4*)(ssq + (size_t)row * 16); const f32x4 a = p[0], b = p[1], c = p[2], d = p[3];
    const float s = (((a[0] + a[1]) + (a[2] + a[3])) + ((b[0] + b[1]) + (b[2] + b[3]))) + (((c[0] + c[1]) + (c[2] + c[3])) + ((d[0] + d[1]) + (d[2] + d[3])));
    return __builtin_amdgcn_rsqf(s * (1.0f / 1024.0f) + EPS);
}
__device__ __forceinline__ float sigmoidf_fast(float x) { return __builtin_amdgcn_rcpf(1.0f + __builtin_amdgcn_exp2f(-x * LOG2E)); }
__device__ __forceinline__ u32x2 pack4(const f32x4 v) { u32x2 w; w.x = cvt_pk_bf16(v[0], v[1]); w.y = cvt_pk_bf16(v[2], v[3]); return w; }
__device__ __forceinline__ unsigned pk_f16(float lo, float hi) { f16x2 h; h.x = (_Float16)lo; h.y = (_Float16)hi; return __builtin_bit_cast(unsigned, h); }
__device__ __forceinline__ u32x2 pack4h(const f32x4 v) { u32x2 w; w.x = pk_f16(v[0], v[1]); w.y = pk_f16(v[2], v[3]); return w; }
__device__ __forceinline__ f32x4 unpack4(const u32x2 w) { f32x4 v; v[0] = __uint_as_float(w.x << 16); v[1] = __uint_as_float(w.x & 0xffff0000u); v[2] = __uint_as_float(w.y << 16); v[3] = __uint_as_float(w.y & 0xffff0000u); return v; }


struct EpiGateUp {
    static constexpr bool PERM = false, AFTER_DRAIN = false;
    bf16_t* H; const float* ssq;
    __device__ __forceinline__ void operator()(const f32x4 (&acc)[2][2][4][2], const Unit& u, int wr, int wc, int fr, int fq) const {
#pragma unroll
        for (int ai = 0; ai < 2; ++ai)
#pragma unroll
            for (int m = 0; m < 4; ++m) {
                const int row = u.pm * 256 + ai * 128 + wr * 64 + m * 16 + fr; const float rs = row_rs(ssq, row);
                bf16_t* hp = H + (size_t)row * FF + u.pn * 128 + wc * 16 + fq * 4;
#pragma unroll
                for (int bj = 0; bj < 2; ++bj) { const f32x4 g = acc[ai][bj][m][0] * rs, up = acc[ai][bj][m][1] * rs; f32x4 h;
#pragma unroll
                    for (int e = 0; e < 4; ++e) h[e] = g[e] * sigmoidf_fast(g[e]) * up[e];
                    *(u32x2*)(hp + bj * 64) = pack4(h); }
            }
    }
};

struct EpiResid {
    static constexpr bool PERM = false, AFTER_DRAIN = false;
    const float* res; float* out; bf16_t* xb; float* ssq; float alpha;
    __device__ __forceinline__ void operator()(const f32x4 (&acc)[2][2][4][2], const Unit& u, int wr, int wc, int fr, int fq) const {
#pragma unroll
        for (int ai = 0; ai < 2; ++ai)
#pragma unroll
            for (int m = 0; m < 4; ++m) {
                const int row = u.pm * 256 + ai * 128 + wr * 64 + m * 16 + fr; const size_t off = (size_t)row * DM + u.pn * 256 + wc * 32 + fq * 4; float q = 0.f;
#pragma unroll
                for (int bj = 0; bj < 2; ++bj)
#pragma unroll
                    for (int n = 0; n < 2; ++n) { const size_t o2 = off + bj * 128 + n * 16; const f32x4 r = *(const f32x4*)(res + o2); const f32x4 o = r + acc[ai][bj][m][n] * alpha;
                        *(f32x4*)(out + o2) = o; q += (o[0] * o[0] + o[1] * o[1]) + (o[2] * o[2] + o[3] * o[3]);
                        if (xb) *(u32x2*)(xb + o2) = pack4(o); }
                q += __shfl_xor(q, 16); q += __shfl_xor(q, 32);
                if (fq == 0) ssq[(size_t)row * 16 + u.pn * 4 + wc] = q;
            }
    }
};

template <bool SECOND> struct EpiBranch {
    static constexpr bool PERM = false, AFTER_DRAIN = false;
    const bf16_t* sg; bf16_t* t1; bf16_t* outp;
    __device__ __forceinline__ void operator()(const f32x4 (&acc)[2][2][4][2], const Unit& u, int wr, int wc, int fr, int fq) const {
#pragma unroll
        for (int ai = 0; ai < 2; ++ai)
#pragma unroll
            for (int m = 0; m < 4; ++m) {
                const int row = u.pm * 256 + ai * 128 + wr * 64 + m * 16 + fr; const size_t off = (size_t)row * DM + u.pn * 256 + wc * 32 + fq * 4;
#pragma unroll
                for (int bj = 0; bj < 2; ++bj)
#pragma unroll
                    for (int n = 0; n < 2; ++n) { const size_t o2 = off + bj * 128 + n * 16; const f32x4 g = unpack4(*(const u32x2*)(sg + o2)); f32x4 o = g * acc[ai][bj][m][n];
                        if (SECOND) o = o + unpack4(*(const u32x2*)(t1 + o2));
                        *(u32x2*)((SECOND ? outp : t1) + o2) = pack4(o); }
            }
    }
};

struct EpiInProj {
    static constexpr bool PERM = false, AFTER_DRAIN = false;
    const float* ssq; const float* cosT; const float* sinT;
    bf16_t *QA, *KA, *VA, *QS, *KS, *VS, *SGA, *SGB; unsigned short *QI, *KI; float* WI; int meta;
    template <int MODE  > static __device__ __forceinline__ void rope_store(unsigned short* d, const f32x4 x1, const f32x4 x2, const f32x4 c, const f32x4 s, float sc) {
        const f32x4 o1 = (x1 * c - x2 * s) * sc, o2 = (x2 * c + x1 * s) * sc;
        if (MODE == 0) { *(u32x2*)d = pack4(o1); *(u32x2*)(d + 32) = pack4(o2); } else { *(u32x2*)d = pack4h(o1); *(u32x2*)(d + 32) = pack4h(o2); }
    }
    __device__ __forceinline__ void operator()(const f32x4 (&acc)[2][2][4][2], const Unit& u, int wr, int wc, int fr, int fq) const {
        const int pn = u.pn, g = wc & 1, hq = wc >> 1;
#pragma unroll
        for (int ai = 0; ai < 2; ++ai)
#pragma unroll
            for (int m = 0; m < 4; ++m) {
                const int rloc = ai * 128 + wr * 64 + m * 16 + fr, row = u.pm * 256 + rloc;
                if (meta && (ai | wr | m)) continue;
                const float rs = row_rs(ssq, row);
                int pos, krow; if (!meta) { const int b = row >> 12, t = row & 4095; pos = 16 + t; krow = b * NKV + 128 + t; } else { pos = rloc; krow = 112 + rloc; }
                const int nrep = meta ? BATCH : 1;
                if (pn < 7) {
                    const f32x4 c4 = *(const f32x4*)(cosT + pos * 32 + 16 * g + 4 * fq), s4 = *(const f32x4*)(sinT + pos * 32 + 16 * g + 4 * fq);
                    const int i0 = 16 * g + 4 * fq;
#pragma unroll
                    for (int bj = 0; bj < 2; ++bj) {
                        const f32x4 v0 = acc[ai][bj][m][0] * rs, v1 = acc[ai][bj][m][1] * rs;
                        if (pn <= 1) { if (!meta) rope_store<0>(QA + (size_t)row * 512 + (pn * 4 + bj * 2 + hq) * 64 + i0, v0, v1, c4, s4, QSCALE); }
                        else if (pn == 3) { if (!meta) rope_store<1>(QI + (size_t)row * 256 + (bj * 2 + hq) * 64 + i0, v0, v1, c4, s4, 1.0f); }
                        else if (pn <= 5 && pn >= 4) { if (!meta) rope_store<0>(QS + (size_t)row * 512 + ((pn - 4) * 4 + bj * 2 + hq) * 64 + i0, v0, v1, c4, s4, QSCALE); }
                        else if (pn == 2) {
                            for (int rep = 0; rep < nrep; ++rep) { const size_t kr = (size_t)krow + (size_t)rep * NKV;
                                if (bj == 0) { if (wc < 2) rope_store<0>(KA + kr * 64 + i0, v0, v1, c4, s4, 1.0f);
                                               else { bf16_t* d = VA + kr * 64 + 32 * (wc - 2) + 4 * fq; *(u32x2*)d = pack4(v0); *(u32x2*)(d + 16) = pack4(v1); } }
                                else if (wc < 2) rope_store<1>(KI + kr * 64 + i0, v0, v1, c4, s4, 1.0f); }
                            if (bj == 1 && wc == 2 && fq == 0 && !meta) *(f32x4*)(WI + (size_t)row * 4) = v0 * IDX_SCALE;
                        } else {
                            for (int rep = 0; rep < nrep; ++rep) { const size_t kr = (size_t)krow + (size_t)rep * NKV;
                                if (bj == 0) rope_store<0>(KS + kr * 128 + hq * 64 + i0, v0, v1, c4, s4, 1.0f);
                                else { bf16_t* d = VS + kr * 128 + 32 * wc + 4 * fq; *(u32x2*)d = pack4(v0); *(u32x2*)(d + 16) = pack4(v1); } }
                        }
                    }
                } else if (!meta) {
                    bf16_t* d = (pn < 11 ? SGA + (size_t)(pn - 7) * 256 : SGB + (size_t)(pn - 11) * 256) + (size_t)row * DM + wc * 32 + fq * 4;
#pragma unroll
                    for (int bj = 0; bj < 2; ++bj)
#pragma unroll
                        for (int n = 0; n < 2; ++n) { const f32x4 v = acc[ai][bj][m][n] * rs; f32x4 o;
#pragma unroll
                            for (int e = 0; e < 4; ++e) o[e] = sigmoidf_fast(v[e]);
                            *(u32x2*)(d + bj * 128 + n * 16) = pack4(o); }
                }
            }
    }
};
}

namespace att {
#define ALAS __attribute__((address_space(3)))
typedef _Float16 f16x8 __attribute__((ext_vector_type(8)));
typedef short bf16x8 __attribute__((ext_vector_type(8)));
typedef short s16x4 __attribute__((ext_vector_type(4)));
typedef float f32x16 __attribute__((ext_vector_type(16)));
typedef float f32x4 __attribute__((ext_vector_type(4)));
typedef unsigned u32x4 __attribute__((ext_vector_type(4)));
typedef unsigned u32x2 __attribute__((ext_vector_type(2)));
typedef unsigned short u16;

constexpr int L_MASK = 131072, MASK_W = 136;
constexpr int L_QINFO = L_MASK + 32 * MASK_W * 4;
constexpr int L_WSF = L_QINFO + 512;
constexpr int L_END = L_WSF + 8 * 64 * 4;
constexpr int L_KBUF = 0, L_VBUF = 32768, L_OST = 65536;
constexpr int CAND_CAP = 512;

__device__ __forceinline__ int crow(int r, int hi) { return (r & 3) + 8 * (r >> 2) + 4 * hi; }
__device__ __forceinline__ unsigned swap_or(unsigned w) { auto rr = __builtin_amdgcn_permlane32_swap(w, w, false, false); return rr[0] | rr[1]; }
__device__ __forceinline__ float swap_max(float m) { auto rr = __builtin_amdgcn_permlane32_swap(__float_as_uint(m), __float_as_uint(m), false, false); return fmaxf(__uint_as_float(rr[0]), __uint_as_float(rr[1])); }
__device__ __forceinline__ float swap_add(float m) { auto rr = __builtin_amdgcn_permlane32_swap(__float_as_uint(m), __float_as_uint(m), false, false); return __uint_as_float(rr[0]) + __uint_as_float(rr[1]); }

__device__ __forceinline__ void select_unit(ALAS unsigned char* lds, int b, int qt, const u16* QI, const u16* KI, const float* WI, unsigned* err) {
    const int tid = threadIdx.x, lane = tid & 63, r32 = lane & 31, hi = lane >> 5; const int wid = __builtin_amdgcn_readfirstlane(tid >> 6);
    ALAS unsigned* hist = (ALAS unsigned*)lds;
    ALAS unsigned* maskw = (ALAS unsigned*)(lds + L_MASK);
    ALAS unsigned* qinfo = (ALAS unsigned*)(lds + L_QINFO);
    ALAS u32x2* cand = (ALAS u32x2*)lds;
    { ALAS u32x4* z = (ALAS u32x4*)lds; const u32x4 zero = {0u, 0u, 0u, 0u};
      for (int i = tid; i < (L_WSF / 16); i += 512) z[i] = zero; }
    const size_t row0 = (size_t)b * SEQ + 32 * qt;
    f16x8 qf[4][4];
#pragma unroll
    for (int h = 0; h < 4; ++h)
#pragma unroll
        for (int ks = 0; ks < 4; ++ks) qf[h][ks] = *(const f16x8*)(QI + (row0 + r32) * 256 + h * 64 + ks * 16 + hi * 8);
    const f32x4 w4 = *(const f32x4*)(WI + (row0 + r32) * 4);
    const int sq = 128 + 32 * qt + r32;
    __syncthreads();
    for (int pass = 0; pass < 2; ++pass) {
        unsigned binstar = 0u; if (pass) binstar = qinfo[r32 * 4 + 0];
        for (int kb = 3 + wid; kb <= 4 + qt; kb += 8) {
            const u16* kp = KI + ((size_t)b * NKV + kb * 32 + r32) * 64 + hi * 8;
            f16x8 kf[4];
#pragma unroll
            for (int ks = 0; ks < 4; ++ks) kf[ks] = *(const f16x8*)(kp + ks * 16);
            f32x16 a0 = {}, a1 = {}, a2 = {}, a3 = {};
#pragma unroll
            for (int ks = 0; ks < 4; ++ks) {
                a0 = __builtin_amdgcn_mfma_f32_32x32x16_f16(kf[ks], qf[0][ks], a0, 0, 0, 0);
                a1 = __builtin_amdgcn_mfma_f32_32x32x16_f16(kf[ks], qf[1][ks], a1, 0, 0, 0);
                a2 = __builtin_amdgcn_mfma_f32_32x32x16_f16(kf[ks], qf[2][ks], a2, 0, 0, 0);
                a3 = __builtin_amdgcn_mfma_f32_32x32x16_f16(kf[ks], qf[3][ks], a3, 0, 0, 0);
            }
            unsigned wpart = 0u;
#pragma unroll
            for (int r = 0; r < 16; ++r) {
                float sc = w4[0] * fmaxf(a0[r], 0.f); sc = fmaf(w4[1], fmaxf(a1[r], 0.f), sc); sc = fmaf(w4[2], fmaxf(a2[r], 0.f), sc); sc = fmaf(w4[3], fmaxf(a3[r], 0.f), sc);
                sc += 0.0f;
                const int s = kb * 32 + crow(r, hi); const bool valid = (s >= 112) && (s <= sq);
                const unsigned bits = __float_as_uint(sc);
                int idx = (int)((bits & 0x7fffffffu) >> 18) - 3551; idx = idx < 0 ? 0 : (idx > 705 ? 705 : idx);
                const unsigned bin = (bits >> 31) ? (unsigned)(1023 - idx) : (unsigned)(1024 + idx);
                if (pass == 0) {
                    if (valid) __hip_atomic_fetch_add(hist + r32 * 1024 + (bin >> 1), 1u << ((bin & 1u) * 16u), __ATOMIC_RELAXED, __HIP_MEMORY_SCOPE_WORKGROUP);
                } else {
                    if (valid && bin > binstar) wpart |= 1u << crow(r, 0);
                    if (valid && bin == binstar) {
                        const unsigned slot = __hip_atomic_fetch_add(qinfo + r32 * 4 + 2, 1u, __ATOMIC_RELAXED, __HIP_MEMORY_SCOPE_WORKGROUP);
                        if (slot < (unsigned)CAND_CAP) { u32x2 e; e.x = bits ^ ((unsigned)((int)bits >> 31) | 0x80000000u); e.y = (unsigned)s; cand[r32 * CAND_CAP + slot] = e; }
                    }
                }
            }
            if (pass) { const unsigned word = swap_or(wpart << (4 * hi)); if (hi == 0) maskw[r32 * MASK_W + kb] = word; }
        }
        __syncthreads();
        if (pass == 0) {
            for (int qq = 0; qq < 4; ++qq) {
                const int q = wid * 4 + qq; int kq = 32 * qt + q + 17; kq = kq > 256 ? 256 : kq;
                const ALAS u32x4* hp = (const ALAS u32x4*)(hist + q * 1024 + lane * 16);
                unsigned sum = 0u;
#pragma unroll
                for (int i = 0; i < 4; ++i) { const u32x4 w = hp[i]; sum += ((w.x & 0xffffu) + (w.x >> 16)) + ((w.y & 0xffffu) + (w.y >> 16)) + ((w.z & 0xffffu) + (w.z >> 16)) + ((w.w & 0xffffu) + (w.w >> 16)); }
                unsigned I = sum;
#pragma unroll
                for (int o = 1; o < 64; o <<= 1) { const unsigned y = __shfl_down(I, o); if (lane + o < 64) I += y; }
                const unsigned above = I - sum; const bool hit = (I >= (unsigned)kq) && (above < (unsigned)kq);
                const unsigned long long bal = __ballot(hit);
                const int lstar = bal ? (__ffsll((long long)bal) - 1) : 0;
                const unsigned aboveS = __shfl(above, lstar);
                unsigned c = 0u; if (lane < 32) { const unsigned wv = hist[q * 1024 + lstar * 16 + (lane >> 1)]; c = (lane & 1) ? (wv >> 16) : (wv & 0xffffu); }
                unsigned I2 = c;
#pragma unroll
                for (int o = 1; o < 32; o <<= 1) { const unsigned y = __shfl_down(I2, o); if (lane + o < 64) I2 += y; }
                const bool hit2 = (lane < 32) && (aboveS + I2 >= (unsigned)kq) && (aboveS + I2 - c < (unsigned)kq);
                if (hit2) { qinfo[q * 4 + 0] = (unsigned)(lstar * 32 + lane); qinfo[q * 4 + 1] = aboveS + I2 - c; qinfo[q * 4 + 3] = (unsigned)kq; }
            }
            __syncthreads();
        }
    }
    for (int qq = 0; qq < 4; ++qq) {
        const int q = wid * 4 + qq; const unsigned nraw = qinfo[q * 4 + 2]; const int n = nraw > (unsigned)CAND_CAP ? CAND_CAP : (int)nraw;
        const int rneed = (int)qinfo[q * 4 + 3] - (int)qinfo[q * 4 + 1];
        if (nraw > (unsigned)CAND_CAP && lane == 0) atomicOr(err, 2u);
        for (int i0 = 0; i0 < n; i0 += 64) {
            const int i = i0 + lane; const bool act = i < n; u32x2 me = {0u, 0u}; if (act) me = cand[q * CAND_CAP + i];
            int rank = 0;
            for (int j = 0; j < n; ++j) { const u32x2 o = cand[q * CAND_CAP + j]; rank += ((o.x > me.x) || (o.x == me.x && o.y < me.y)) ? 1 : 0; }
            if (act && rank < rneed) __hip_atomic_fetch_or(maskw + q * MASK_W + (me.y >> 5), 1u << (me.y & 31u), __ATOMIC_RELAXED, __HIP_MEMORY_SCOPE_WORKGROUP);
        }
    }
    __syncthreads();
}

__device__ __forceinline__ void pv(f32x16* o, int vb, bf16x8 pa0, bf16x8 pa1, bf16x8 pa2, bf16x8 pa3) {
#pragma unroll
    for (int d0 = 0; d0 < 2; ++d0) { s16x4 lo[4], hi[4];
#pragma unroll
        for (int ks = 0; ks < 4; ++ks) {
            asm volatile("ds_read_b64_tr_b16 %0,%1 offset:%c2" : "=&v"(lo[ks]) : "v"(vb), "i"(d0 * 4096 + ks * 1024) : "memory");
            asm volatile("ds_read_b64_tr_b16 %0,%1 offset:%c2" : "=&v"(hi[ks]) : "v"(vb), "i"(d0 * 4096 + ks * 1024 + 512) : "memory"); }
        asm volatile("s_waitcnt lgkmcnt(0)" ::: "memory"); __builtin_amdgcn_sched_barrier(0);
#define ATT_PK(k) (bf16x8){lo[k][0], lo[k][1], lo[k][2], lo[k][3], hi[k][0], hi[k][1], hi[k][2], hi[k][3]}
        o[d0] = __builtin_amdgcn_mfma_f32_32x32x16_bf16(pa0, ATT_PK(0), o[d0], 0, 0, 0);
        o[d0] = __builtin_amdgcn_mfma_f32_32x32x16_bf16(pa1, ATT_PK(1), o[d0], 0, 0, 0);
        o[d0] = __builtin_amdgcn_mfma_f32_32x32x16_bf16(pa2, ATT_PK(2), o[d0], 0, 0, 0);
        o[d0] = __builtin_amdgcn_mfma_f32_32x32x16_bf16(pa3, ATT_PK(3), o[d0], 0, 0, 0);
#undef ATT_PK
    }
}

template <bool SWA> __device__ __forceinline__ void attn_unit(ALAS unsigned char* lds, int b, int qt, const u16* Q, const u16* K, const u16* V, u16* O, float sink2) {
    constexpr int KP = SWA ? 128 : 64, NH = SWA ? 2 : 1;
    const int tid = threadIdx.x, lane = tid & 63, r32 = lane & 31, hi = lane >> 5; const int wid = __builtin_amdgcn_readfirstlane(tid >> 6);
    const int kvh = SWA ? (wid >> 2) : 0;
    const size_t row0 = (size_t)b * SEQ + 32 * qt;
    bf16x8 qr[4];
#pragma unroll
    for (int d0 = 0; d0 < 4; ++d0) qr[d0] = *(const bf16x8*)(Q + (row0 + r32) * 512 + wid * 64 + d0 * 16 + hi * 8);
    const int sq = 128 + 32 * qt + r32;
    const int j_lo = SWA ? (qt >> 1) : 1, j_hi = (qt >> 1) + 2;
    const u16* Kb = K + (size_t)b * NKV * KP; const u16* Vb = V + (size_t)b * NKV * KP;
    const int skey = tid & 63, schunk = tid >> 6;
    const int vrow = 16 * ((tid >> 6) & 3) + (lane >> 2), vdh = tid >> 8, vpc = lane & 3;
    ALAS const unsigned* maskw = (ALAS const unsigned*)(lds + L_MASK) + r32 * MASK_W;
    ALAS float* wsf = (ALAS float*)(lds + L_WSF) + wid * 64;
    u32x4 kreg[NH], vreg[NH];
#define ATT_LOAD(j) do { _Pragma("unroll") for (int hd = 0; hd < NH; ++hd) { \
        kreg[hd] = *(const u32x4*)(Kb + (size_t)(64 * (j) + skey) * KP + hd * 64 + schunk * 8); \
        vreg[hd] = *(const u32x4*)(Vb + (size_t)(64 * (j) + vrow) * KP + hd * 64 + vdh * 32 + vpc * 8); } } while (0)
#define ATT_STORE(buf) do { _Pragma("unroll") for (int hd = 0; hd < NH; ++hd) { \
        *(ALAS u32x4*)(lds + L_KBUF + (buf) * 16384 + hd * 8192 + tid * 16) = kreg[hd]; \
        *(ALAS u32x4*)(lds + L_VBUF + (buf) * 16384 + hd * 8192 + tid * 16) = vreg[hd]; } } while (0)
    float m_run = SWA ? sink2 : -1.0e4f, lsum = (SWA && hi == 0) ? 1.0f : 0.0f;
    f32x16 o[2]; o[0] = f32x16{}; o[1] = f32x16{};
    ATT_LOAD(j_lo); ATT_STORE(0);
    __syncthreads();
    int cur = 0;
    for (int j = j_lo; j <= j_hi; ++j) {
        const bool more = j < j_hi;
        if (more) ATT_LOAD(j + 1);
        f32x16 p0 = f32x16{}, p1 = f32x16{};
        { ALAS const unsigned char* kb = lds + L_KBUF + cur * 16384 + kvh * 8192 + hi * 1024 + r32 * 16;
#pragma unroll
          for (int d0 = 0; d0 < 4; ++d0) { const bf16x8 b0 = *(ALAS const bf16x8*)(kb + d0 * 2048), b1 = *(ALAS const bf16x8*)(kb + d0 * 2048 + 512);
              p0 = __builtin_amdgcn_mfma_f32_32x32x16_bf16(b0, qr[d0], p0, 0, 0, 0); p1 = __builtin_amdgcn_mfma_f32_32x32x16_bf16(b1, qr[d0], p1, 0, 0, 0); } }
        unsigned w0, w1;
        if (SWA) {
            const int los = (sq - 127) > 112 ? (sq - 127) : 112;
            { const int base = 64 * j; const int a = los - base, e = sq - base; const int a2 = a < 0 ? 0 : a, e2 = e > 31 ? 31 : e;
              w0 = (a2 > 31 || e2 < 0 || a2 > e2) ? 0u : ((0xffffffffu >> (31 - e2)) & (0xffffffffu << a2)); }
            { const int base = 64 * j + 32; const int a = los - base, e = sq - base; const int a2 = a < 0 ? 0 : a, e2 = e > 31 ? 31 : e;
              w1 = (a2 > 31 || e2 < 0 || a2 > e2) ? 0u : ((0xffffffffu >> (31 - e2)) & (0xffffffffu << a2)); }
        } else { w0 = maskw[2 * j]; w1 = maskw[2 * j + 1]; }
        w0 >>= 4 * hi; w1 >>= 4 * hi;
        const float NEG = -INFINITY;
#pragma unroll
        for (int r = 0; r < 16; ++r) { p0[r] = ((w0 >> crow(r, 0)) & 1u) ? p0[r] : NEG; p1[r] = ((w1 >> crow(r, 0)) & 1u) ? p1[r] : NEG; }
        float tm = fmaxf(p0[0], p1[0]);
#pragma unroll
        for (int r = 1; r < 16; ++r) tm = fmaxf(tm, fmaxf(p0[r], p1[r]));
        tm = swap_max(tm);
        if (__any(tm > m_run)) {
            const float mn = fmaxf(m_run, tm), alpha = __builtin_amdgcn_exp2f(m_run - mn);
            lsum *= alpha; m_run = mn;
            if (hi == 0) wsf[r32] = alpha;
            asm volatile("s_waitcnt lgkmcnt(0)" ::: "memory");
#pragma unroll
            for (int r = 0; r < 16; ++r) { const float f = wsf[crow(r, hi)]; o[0][r] *= f; o[1][r] *= f; }
        }
        float sacc = 0.f;
#pragma unroll
        for (int r = 0; r < 16; ++r) { p0[r] = __builtin_amdgcn_exp2f(p0[r] - m_run); p1[r] = __builtin_amdgcn_exp2f(p1[r] - m_run); sacc += p0[r] + p1[r]; }
        lsum += sacc;
        u32x4 pw0, pw1, pw2, pw3;
#define ATT_PKW(P, B) pg8::cvt_pk_bf16(P[B], P[B + 1])
        pw0 = (u32x4){ATT_PKW(p0, 0), ATT_PKW(p0, 2), ATT_PKW(p0, 4), ATT_PKW(p0, 6)}; pw1 = (u32x4){ATT_PKW(p0, 8), ATT_PKW(p0, 10), ATT_PKW(p0, 12), ATT_PKW(p0, 14)};
        pw2 = (u32x4){ATT_PKW(p1, 0), ATT_PKW(p1, 2), ATT_PKW(p1, 4), ATT_PKW(p1, 6)}; pw3 = (u32x4){ATT_PKW(p1, 8), ATT_PKW(p1, 10), ATT_PKW(p1, 12), ATT_PKW(p1, 14)};
#undef ATT_PKW
        const int vb = (int)(size_t)(lds + L_VBUF + cur * 16384 + kvh * 8192) + ((lane >> 4) & 1) * 32 + (lane & 3) * 8 + (4 * hi + ((lane & 15) >> 2)) * 64;
        pv(o, vb, __builtin_bit_cast(bf16x8, pw0), __builtin_bit_cast(bf16x8, pw1), __builtin_bit_cast(bf16x8, pw2), __builtin_bit_cast(bf16x8, pw3));
        if (more) ATT_STORE(cur ^ 1);
        __syncthreads();
        cur ^= 1;
    }
#undef ATT_LOAD
#undef ATT_STORE
    lsum = swap_add(lsum);
    if (hi == 0) wsf[32 + r32] = lsum;
    asm volatile("s_waitcnt lgkmcnt(0)" ::: "memory");
    ALAS u16* stg = (ALAS u16*)(lds + L_OST + wid * 4096);
#pragma unroll
    for (int r = 0; r < 16; ++r) { const int orow = crow(r, hi); const float rl = __builtin_amdgcn_rcpf(wsf[32 + orow]);
#pragma unroll
        for (int d0 = 0; d0 < 2; ++d0) stg[orow * 64 + d0 * 32 + r32] = (u16)(pg8::cvt_pk_bf16(o[d0][r] * rl, 0.f) & 0xffffu); }
    asm volatile("s_waitcnt lgkmcnt(0)" ::: "memory");
#pragma unroll
    for (int i = 0; i < 4; ++i) { const int row = i * 8 + (lane >> 3), ch = lane & 7; const u32x4 v = *(ALAS const u32x4*)(stg + row * 64 + ch * 8);
        *(u32x4*)(O + (row0 + row) * 512 + wid * 64 + ch * 8) = v; }
    asm volatile("s_waitcnt lgkmcnt(0)" ::: "memory");
}
}

constexpr int NWAVES = 8;
constexpr int N_LAUNCHES = MK_N_LAUNCHES;
constexpr int PER_PHASE = 10;

constexpr size_t MiB = 1u << 20;
constexpr size_t WS_CTL = 0, CTL_ZERO_BYTES = 1 * MiB;
constexpr size_t WS_W1T = 1 * MiB, WS_WD1T = 12 * MiB, WS_WINT = 18 * MiB, WS_WBST = 26 * MiB, WS_WBWT = 27 * MiB, WS_WOUTT = 28 * MiB, WS_W2T = 30 * MiB, WS_WD2T = 41 * MiB;
constexpr size_t WS_COS = 47 * MiB, WS_SIN = 48 * MiB;
constexpr size_t WS_SSQ0 = 49 * MiB, WS_SSQ1 = 51 * MiB, WS_SSQ2 = 53 * MiB, WS_SSQ3 = 55 * MiB;
constexpr size_t WS_WI = 57 * MiB, WS_KA = 58 * MiB, WS_VA = 63 * MiB, WS_KI = 68 * MiB, WS_KS = 73 * MiB, WS_VS = 82 * MiB;
constexpr size_t WS_AM = 91 * MiB, WS_SSQM0 = 91 * MiB + 512 * 1024, WS_SSQM1 = 91 * MiB + 768 * 1024, WS_HM = 92 * MiB, WS_XBM = 93 * MiB + 512 * 1024, WS_H0M = 94 * MiB, WS_H1M = 95 * MiB;
constexpr size_t WS_XB = 96 * MiB;
constexpr size_t WS_HFF = 160 * MiB;
constexpr size_t WS_QA = 160 * MiB, WS_QS = 192 * MiB, WS_QI = 224 * MiB, WS_OSP = 240 * MiB, WS_OSW = 272 * MiB, WS_MERGED = 160 * MiB;
constexpr size_t WS_SGA = 336 * MiB, WS_SGB = 400 * MiB, WS_END = 464 * MiB;
constexpr int CW_ERR = 0;
constexpr int CW_BAR = 4096;

constexpr int RING_OFF = 0, RING_BYTES = 131072;
constexpr int LDSCTL_OFF = 151552, MISC_OFF = LDSCTL_OFF + 320;
constexpr int LDS_BYTES = 155648;
static_assert(att::L_END <= LDSCTL_OFF && MISC_OFF + 128 <= LDS_BYTES, "LDS map");

#define GAS __attribute__((address_space(1)))
#define LAS __attribute__((address_space(3)))
typedef unsigned short bf16;
typedef unsigned v4u __attribute__((ext_vector_type(4)));
typedef float f32x4 __attribute__((ext_vector_type(4)));
typedef GAS unsigned gu32;
#define RLX_AGENT __ATOMIC_RELAXED, __HIP_MEMORY_SCOPE_AGENT
#define LDS_WAIT() asm volatile("s_waitcnt lgkmcnt(0)" ::: "memory")
__device__ __forceinline__ unsigned f2bf(float f) { unsigned u = __builtin_bit_cast(unsigned, f); return (u + 0x7fffu + ((u >> 16) & 1u)) >> 16; }
__device__ __forceinline__ unsigned pk2(float lo, float hi) { return f2bf(lo) | (f2bf(hi) << 16); }
#define XB_TMO      128
#define XB_XCNT(j)  (256  + 64 * (j))
#define XB_XSUB(j)  (1280 + 64 * (j))
#define XB_XGEN(j)  (2304 + 64 * (j))
#define XB_TOP      3328
#define XB_TOPGEN   3392
#define XCD_BAR_WORDS 3456
#define XB_SPIN_CAP (1u << 22)

__device__ __forceinline__ unsigned xb_ld(unsigned* p)              { return __hip_atomic_load(p, __ATOMIC_RELAXED, __HIP_MEMORY_SCOPE_AGENT); }
__device__ __forceinline__ unsigned xb_add(unsigned* p, unsigned v) { return __hip_atomic_fetch_add(p, v, __ATOMIC_RELAXED, __HIP_MEMORY_SCOPE_AGENT); }
__device__ __forceinline__ unsigned xb_xcc_id() { return (unsigned)__builtin_amdgcn_s_getreg((3 << 11) | 20) & 0xFu; }
#define XB_SPIN(cond, bar) do { unsigned _sp = 0; while (cond) { __builtin_amdgcn_s_sleep(1); \
    if ((++_sp & 255u) == 0u) { if (xb_ld(&(bar)[XB_TMO])) break; if (_sp > XB_SPIN_CAP) { atomicAdd(&(bar)[XB_TMO], 1u); break; } } } } while (0)

struct XcdBarrier {
    unsigned* bar; unsigned x;
    volatile LAS unsigned* st;
};

__device__ __forceinline__ XcdBarrier xcd_barrier_post(unsigned* bar, volatile LAS unsigned* st) {
    XcdBarrier b; b.bar = bar; b.x = xb_xcc_id(); b.st = st;
    if (threadIdx.x == 0) (void)xb_add(&bar[XB_XCNT(b.x)], 1u);
    return b;
}
__device__ __forceinline__ void xcd_barrier_complete(unsigned* bar, unsigned x, unsigned& nloc, unsigned& nx) {
    const unsigned G = gridDim.x * gridDim.y * gridDim.z;
    unsigned sum, cnt, mine, sp = 0u;
    for (;;) {
        sum = 0u; cnt = 0u; mine = 0u;
#pragma unroll
        for (unsigned j = 0; j < 16; ++j) { const unsigned c = xb_ld(&bar[XB_XCNT(j)]); sum += c; cnt += (c > 0u) ? 1u : 0u; mine = (j == x) ? c : mine; }
        if (sum == G) break;
        __builtin_amdgcn_s_sleep(1);
        if ((++sp & 255u) == 0u) { if (xb_ld(&bar[XB_TMO])) break; if (sp > XB_SPIN_CAP) { atomicAdd(&bar[XB_TMO], 1u); break; } }
    }
    nloc = mine > 0u ? mine : 1u; nx = cnt > 0u ? cnt : 1u;
}

__device__ __forceinline__ void xcd_barrier(const XcdBarrier& b) {
    asm volatile("s_waitcnt vmcnt(0)" ::: "memory");
    __syncthreads();
    if (threadIdx.x == 0) {
        unsigned* bar = b.bar;
        __builtin_amdgcn_s_waitcnt(0);
        unsigned nloc = b.st[0], nx = b.st[1];
        if (nloc == 0u) { xcd_barrier_complete(bar, b.x, nloc, nx); b.st[0] = nloc; b.st[1] = nx; }
        const unsigned old = xb_add(&bar[XB_XSUB(b.x)], 1u);
        const unsigned gen = old / nloc;
        if (old + 1u == (gen + 1u) * nloc) {
            __builtin_amdgcn_fence(__ATOMIC_RELEASE, "agent");
            asm volatile("s_waitcnt vmcnt(0)" ::: "memory");
            const unsigned og = xb_add(&bar[XB_TOP], 1u);
            const unsigned tg = og / nx;
            if (og + 1u == (tg + 1u) * nx) xb_add(&bar[XB_TOPGEN], 1u);
            else XB_SPIN(xb_ld(&bar[XB_TOPGEN]) == tg, bar);
            __builtin_amdgcn_fence(__ATOMIC_ACQUIRE, "agent");
            xb_add(&bar[XB_XGEN(b.x)], 1u);
            asm volatile("s_waitcnt vmcnt(0)" ::: "memory");
        } else {
            XB_SPIN(xb_ld(&bar[XB_XGEN(b.x)]) == gen, bar);
            __builtin_amdgcn_fence(__ATOMIC_ACQUIRE, "agent");
            asm volatile("s_waitcnt vmcnt(0)" ::: "memory");
        }
    }
    __syncthreads();
}

__device__ __forceinline__ float wave_sum(float v) {
#pragma unroll
    for (int o = 1; o < 64; o <<= 1) v += __shfl_xor(v, o);
    return v;
}
__device__ __forceinline__ int ropepos(int w) { const int i = w & 31, half = w >> 5; return 32 * (i >> 4) + 16 * half + (i & 15); }
struct MapIdent { int off; __device__ __forceinline__ int operator()(int n) const { return off + n; } };
struct MapGateUp { int type; __device__ __forceinline__ int operator()(int j) const { return (j >> 4) * 32 + type * 16 + (j & 15); } };
struct MapInProj { __device__ __forceinline__ int operator()(int n) const {
    if (n < 512) return (n >> 6) * 64 + ropepos(n & 63);
    if (n < 576) return 512 + ropepos(n - 512);
    if (n < 640) return 576 + (n - 576);
    if (n < 896) { const int m = n - 640; return 768 + (m >> 6) * 64 + ropepos(m & 63); }
    if (n < 960) return 640 + ropepos(n - 896);
    if (n < 964) return 704 + (n - 960);
    if (n < 1476) { const int m = n - 964; return 1024 + (m >> 6) * 64 + ropepos(m & 63); }
    if (n < 1604) { const int m = n - 1476; return 1536 + (m >> 6) * 64 + ropepos(m & 63); }
    if (n < 1732) return 1664 + (n - 1604);
    if (n < 2756) return 1792 + (n - 1732);
    return 2816 + (n - 2756);
} };
template <class Map> __device__ __forceinline__ void transpose_item(const float* W, int K, int N, const float* gain, bf16* WT, const Map& map, LAS float* scr, int item, int lane) {
    const int nblk = (N + 31) / 32, kb = item / nblk, nb = item % nblk, k0 = 64 * kb, n0 = 32 * nb, n = n0 + (lane & 31);
#pragma unroll 8
    for (int i = 0; i < 32; ++i) { const int kk = 2 * i + (lane >> 5); float v = 0.f; if (n < N) { v = W[(size_t)(k0 + kk) * N + n]; if (gain) v *= gain[k0 + kk]; } scr[kk * 33 + (lane & 31)] = v; }
    LDS_WAIT(); asm volatile("" ::: "memory");
    const int c = lane & 7;
#pragma unroll
    for (int j = 0; j < 4; ++j) { const int nl = (lane >> 3) + 8 * j; if (n0 + nl < N) { const LAS float* s = scr + (8 * c) * 33 + nl;
        v4u o; o.x = pk2(s[0 * 33], s[1 * 33]); o.y = pk2(s[2 * 33], s[3 * 33]); o.z = pk2(s[4 * 33], s[5 * 33]); o.w = pk2(s[6 * 33], s[7 * 33]);
        *(v4u*)(WT + (size_t)map(n0 + nl) * K + k0 + 8 * c) = o; } }
    LDS_WAIT(); asm volatile("" ::: "memory");
}
__device__ __forceinline__ void row_to_bf16_ssq(const float* xrow, bf16* orow, float* frow, float* ssqrow, int lane, bool zero) {
    const f32x4* xr = (const f32x4*)xrow + lane; f32x4 v[4]; float s = 0.f;
#pragma unroll
    for (int j = 0; j < 4; ++j) { v[j] = zero ? (f32x4){0.f, 0.f, 0.f, 0.f} : xr[64 * j]; s += (v[j][0] * v[j][0] + v[j][1] * v[j][1]) + (v[j][2] * v[j][2] + v[j][3] * v[j][3]); }
    s = wave_sum(s);
    unsigned long long* o8 = (unsigned long long*)orow + lane;
#pragma unroll
    for (int j = 0; j < 4; ++j) { o8[64 * j] = (unsigned long long)pk2(v[j][0], v[j][1]) | ((unsigned long long)pk2(v[j][2], v[j][3]) << 32); if (frow) ((f32x4*)frow + lane)[64 * j] = v[j]; }
    if (lane < 16) ssqrow[lane] = lane == 0 ? s : 0.f;
}

struct Args { const float* in[17]; float* out; unsigned char* ws; int ph_lo, ph_hi, li, pad; };

__global__ void __launch_bounds__(NWAVES * 64, 2) mk_fwd(Args args) {
    extern __shared__ __attribute__((aligned(16))) unsigned char lds_raw[];
    LAS unsigned char* lds = (LAS unsigned char*)lds_raw;
    volatile LAS unsigned* MISC = (volatile LAS unsigned*)(lds + MISC_OFF);
    const int tid = threadIdx.x, lane = tid & 63; const int wave = __builtin_amdgcn_readfirstlane(tid >> 6);
    const int G = gridDim.x; int vcu; { const int bx = blockIdx.x; vcu = (G % 8 == 0) ? (bx % 8) * (G / 8) + bx / 8 : bx; }
    unsigned char* ws = args.ws;
    gu32* ctl = (gu32*)(ws + WS_CTL);
    const float* x = args.in[0];
    bf16 *W1T = (bf16*)(ws + WS_W1T), *WD1T = (bf16*)(ws + WS_WD1T), *WINT = (bf16*)(ws + WS_WINT), *WBST = (bf16*)(ws + WS_WBST), *WBWT = (bf16*)(ws + WS_WBWT),
         *WOUTT = (bf16*)(ws + WS_WOUTT), *W2T = (bf16*)(ws + WS_W2T), *WD2T = (bf16*)(ws + WS_WD2T);
    float *COS = (float*)(ws + WS_COS), *SIN = (float*)(ws + WS_SIN);
    float *SSQ0 = (float*)(ws + WS_SSQ0), *SSQ1 = (float*)(ws + WS_SSQ1), *SSQ2 = (float*)(ws + WS_SSQ2), *SSQ3 = (float*)(ws + WS_SSQ3);
    float* WI = (float*)(ws + WS_WI);
    bf16 *KA = (bf16*)(ws + WS_KA), *VA = (bf16*)(ws + WS_VA), *KI = (bf16*)(ws + WS_KI), *KS = (bf16*)(ws + WS_KS), *VS = (bf16*)(ws + WS_VS);
    bf16 *AM = (bf16*)(ws + WS_AM), *HM = (bf16*)(ws + WS_HM), *XBM = (bf16*)(ws + WS_XBM); float *SSQM0 = (float*)(ws + WS_SSQM0), *SSQM1 = (float*)(ws + WS_SSQM1), *H0M = (float*)(ws + WS_H0M), *H1M = (float*)(ws + WS_H1M);
    bf16 *XB = (bf16*)(ws + WS_XB), *HFF = (bf16*)(ws + WS_HFF), *QA = (bf16*)(ws + WS_QA), *QS = (bf16*)(ws + WS_QS), *QI = (bf16*)(ws + WS_QI), *OSP = (bf16*)(ws + WS_OSP), *OSW = (bf16*)(ws + WS_OSW),
         *MERGED = (bf16*)(ws + WS_MERGED), *SGA = (bf16*)(ws + WS_SGA), *SGB = (bf16*)(ws + WS_SGB), *T1 = XB;
    float* out = args.out;

    for (int u = tid; u < (LDS_BYTES - LDSCTL_OFF) / 4; u += NWAVES * 64) ((LAS unsigned*)(lds + LDSCTL_OFF))[u] = 0u;
    __syncthreads();
    XcdBarrier bar; bar.bar = (unsigned*)(ctl + CW_BAR); bar.x = 0; bar.st = nullptr;
    if (N_LAUNCHES != PER_PHASE) bar = xcd_barrier_post((unsigned*)(ctl + CW_BAR), MISC + 8);
#define GRID_BAR() do { if (N_LAUNCHES != PER_PHASE) xcd_barrier(bar); } while (0)
    const int lo = args.ph_lo, hi = args.ph_hi;
#define IN(k) (lo <= (k) && (k) < hi)
#define BOTH(k) (IN(k) && IN((k) + 1))
    const int gw = vcu * NWAVES + wave, NGW = G * NWAVES;

    if (IN(0)) {
        LAS float* scr = (LAS float*)(lds + RING_OFF + wave * 16384);
        constexpr int I_GU = 16 * 88, I_D = 44 * 32, I_IN = 16 * 119, I_B = 8 * 32, I_O = 16 * 32;
        constexpr int NITEMS = 4 * I_GU + 2 * I_D + I_IN + 2 * I_B + I_O;
        for (int it = gw; it < NITEMS; it += NGW) {
            int r = it;
            if (r < I_GU) { transpose_item(args.in[3], DM, FF, args.in[2], W1T, MapGateUp{0}, scr, r, lane); continue; } r -= I_GU;
            if (r < I_GU) { transpose_item(args.in[4], DM, FF, args.in[2], W1T, MapGateUp{1}, scr, r, lane); continue; } r -= I_GU;
            if (r < I_GU) { transpose_item(args.in[13], DM, FF, args.in[12], W2T, MapGateUp{0}, scr, r, lane); continue; } r -= I_GU;
            if (r < I_GU) { transpose_item(args.in[14], DM, FF, args.in[12], W2T, MapGateUp{1}, scr, r, lane); continue; } r -= I_GU;
            if (r < I_D) { transpose_item(args.in[5], FF, DM, nullptr, WD1T, MapIdent{0}, scr, r, lane); continue; } r -= I_D;
            if (r < I_D) { transpose_item(args.in[15], FF, DM, nullptr, WD2T, MapIdent{0}, scr, r, lane); continue; } r -= I_D;
            if (r < I_IN) { transpose_item(args.in[7], DM, 3780, args.in[6], WINT, MapInProj{}, scr, r, lane); continue; } r -= I_IN;
            if (r < I_B) { transpose_item(args.in[9], 512, DM, nullptr, WBST, MapIdent{0}, scr, r, lane); continue; } r -= I_B;
            if (r < I_B) { transpose_item(args.in[10], 512, DM, nullptr, WBWT, MapIdent{0}, scr, r, lane); continue; } r -= I_B;
            transpose_item(args.in[11], DM, DM, nullptr, WOUTT, MapIdent{0}, scr, r, lane);
        }
        for (int m = gw; m < MR; m += NGW) row_to_bf16_ssq(x + (size_t)m * DM, XB + (size_t)m * DM, nullptr, SSQ0 + (size_t)m * 16, lane, false);
        for (int m = gw; m < 256; m += NGW) row_to_bf16_ssq(args.in[1] + (size_t)(m < NMETA ? m : 0) * DM, AM + (size_t)m * DM, H0M + (size_t)m * DM, SSQM0 + (size_t)m * 16, lane, m >= NMETA);
        const int gt = vcu * (NWAVES * 64) + tid, NGT = G * NWAVES * 64;
        for (int i = gt; i < 4112 * 32; i += NGT) { const int pos = i >> 5, fi = i & 31;
            const float e = (float)(2 * fi) / 64.0f, inv = 1.0f / powf(10000.0f, e), ang = (float)pos * inv;
            COS[i] = (float)cos((double)ang); SIN[i] = (float)sin((double)ang); }
        const v4u zero4 = {0u, 0u, 0u, 0u};
        for (int i = gt; i < BATCH * 112 * 56; i += NGT) { const int c = i % 56, rs = i / 56, b = rs / 112, s = rs % 112; const size_t kr = (size_t)b * NKV + s;
            if (c < 8) *(v4u*)(KA + kr * 64 + c * 8) = zero4; else if (c < 16) *(v4u*)(VA + kr * 64 + (c - 8) * 8) = zero4; else if (c < 24) *(v4u*)(KI + kr * 64 + (c - 16) * 8) = zero4;
            else if (c < 40) *(v4u*)(KS + kr * 128 + (c - 24) * 8) = zero4; else *(v4u*)(VS + kr * 128 + (c - 40) * 8) = zero4; }
        for (int i = gt; i < 60 * 128; i += NGT) *(v4u*)(WINT + (size_t)(708 + i / 128) * DM + (i % 128) * 8) = zero4;
        if (BOTH(0)) GRID_BAR();
    }
    if (IN(1)) {
        { pg8::Gemm g{XB, W1T, MR, 2 * FF, DM}; pg8::StaticOrder S; S.init(MR, 2 * FF, G, (int)blockIdx.x); epi::EpiGateUp E{HFF, SSQ0};
          pg8::gemm_phase<epi::EpiGateUp, pg8::StaticOrder, true, true>(lds + RING_OFF, g, S, E); }
        { pg8::Gemm g{AM, W1T, 256, 2 * FF, DM}; pg8::ListOrder S{22, (int)blockIdx.x, 0, -1}; epi::EpiGateUp E{HM, SSQM0};
          pg8::gemm_phase<epi::EpiGateUp, pg8::ListOrder, true, true>(lds + RING_OFF, g, S, E); }
        if (BOTH(1)) GRID_BAR();
    }
    if (IN(2)) {
        { pg8::Gemm g{HFF, WD1T, MR, DM, FF}; pg8::StaticOrder S; S.init(MR, DM, G, (int)blockIdx.x); epi::EpiResid E{x, out, XB, SSQ1, 0.5f};
          pg8::gemm_phase<epi::EpiResid, pg8::StaticOrder, true, true>(lds + RING_OFF, g, S, E); }
        { pg8::Gemm g{HM, WD1T, 256, DM, FF}; pg8::ListOrder S{4, (int)blockIdx.x, 0, -1}; epi::EpiResid E{H0M, H1M, XBM, SSQM1, 0.5f};
          pg8::gemm_phase<epi::EpiResid, pg8::ListOrder, true, true>(lds + RING_OFF, g, S, E); }
        if (BOTH(2)) GRID_BAR();
    }
    if (IN(3)) {
        { pg8::Gemm g{XB, WINT, MR, NIN, DM}; pg8::StaticOrder S; S.init(MR, NIN, G, (int)blockIdx.x);
          epi::EpiInProj E{SSQ1, COS, SIN, QA, KA, VA, QS, KS, VS, SGA, SGB, QI, KI, WI, 0};
          pg8::gemm_phase<epi::EpiInProj, pg8::StaticOrder, true, true>(lds + RING_OFF, g, S, E); }
        { pg8::Gemm g{XBM, WINT, 256, NIN, DM}; pg8::ListOrder S{2, (int)blockIdx.x, 2, 6};
          epi::EpiInProj E{SSQM1, COS, SIN, QA, KA, VA, QS, KS, VS, SGA, SGB, QI, KI, WI, 1};
          pg8::gemm_phase<epi::EpiInProj, pg8::ListOrder, true, true>(lds + RING_OFF, g, S, E); }
        if (BOTH(3)) GRID_BAR();
    }
    if (IN(4)) {
        const float sink2 = args.in[8][wave] * LOG2E;
        for (int i = 0;; ++i) {
            int b, qt;
            if (G == 256) { if (i >= 4) break; const int j = vcu & 31; b = vcu >> 5; qt = (i == 0) ? j : (i == 1) ? 63 - j : (i == 2) ? 64 + j : 127 - j; }
            else { const int u = vcu + i * G; if (u >= BATCH * 128) break; b = u >> 7; qt = u & 127; }
            att::select_unit(lds, b, qt, QI, KI, WI, (unsigned*)(ctl + CW_ERR));
            att::attn_unit<false>(lds, b, qt, QA, KA, VA, OSP, 0.f);
            att::attn_unit<true>(lds, b, qt, QS, KS, VS, OSW, sink2);
            __syncthreads();
        }
        if (BOTH(4)) GRID_BAR();
    }
    if (IN(5)) {
        { pg8::Gemm g{OSP, WBST, MR, DM, 512}; pg8::StaticOrder S; S.init(MR, DM, G, (int)blockIdx.x); epi::EpiBranch<false> E{SGA, T1, MERGED};
          pg8::gemm_phase<epi::EpiBranch<false>, pg8::StaticOrder, true, true>(lds + RING_OFF, g, S, E); }
        { pg8::Gemm g{OSW, WBWT, MR, DM, 512}; pg8::StaticOrder S; S.init(MR, DM, G, (int)blockIdx.x); epi::EpiBranch<true> E{SGB, T1, MERGED};
          pg8::gemm_phase<epi::EpiBranch<true>, pg8::StaticOrder, true, true>(lds + RING_OFF, g, S, E); }
        if (BOTH(5)) GRID_BAR();
    }
    if (IN(6)) {
        pg8::Gemm g{MERGED, WOUTT, MR, DM, DM}; pg8::StaticOrder S; S.init(MR, DM, G, (int)blockIdx.x); epi::EpiResid E{out, out, XB, SSQ2, 1.0f};
        pg8::gemm_phase<epi::EpiResid, pg8::StaticOrder, true, true>(lds + RING_OFF, g, S, E);
        if (BOTH(6)) GRID_BAR();
    }
    if (IN(7)) {
        pg8::Gemm g{XB, W2T, MR, 2 * FF, DM}; pg8::StaticOrder S; S.init(MR, 2 * FF, G, (int)blockIdx.x); epi::EpiGateUp E{HFF, SSQ2};
        pg8::gemm_phase<epi::EpiGateUp, pg8::StaticOrder, true, true>(lds + RING_OFF, g, S, E);
        if (BOTH(7)) GRID_BAR();
    }
    if (IN(8)) {
        pg8::Gemm g{HFF, WD2T, MR, DM, FF}; pg8::StaticOrder S; S.init(MR, DM, G, (int)blockIdx.x); epi::EpiResid E{out, out, nullptr, SSQ3, 0.5f};
        pg8::gemm_phase<epi::EpiResid, pg8::StaticOrder, true, true>(lds + RING_OFF, g, S, E);
        if (BOTH(8)) GRID_BAR();
    }
    if (IN(9)) {
        const bool bad = __hip_atomic_load(ctl + CW_ERR, RLX_AGENT) != 0u || __hip_atomic_load(ctl + CW_BAR + XB_TMO, RLX_AGENT) != 0u;
        const float* gf = args.in[16];
        for (int m = gw; m < MR; m += NGW) {
            const float rs = bad ? __builtin_nanf("") : epi::row_rs(SSQ3, m);
            f32x4* o = (f32x4*)(out + (size_t)m * DM) + lane;
#pragma unroll
            for (int j = 0; j < 4; ++j) { const f32x4 gv = ((const f32x4*)gf + lane)[64 * j]; o[64 * j] = o[64 * j] * rs * gv; }
        }
    }
#undef IN
#undef BOTH
#undef GRID_BAR
}

extern "C" void kernel_launch(void* const* d_in, const int* in_sizes, int n_in, void* d_out, int out_size, void* d_ws, size_t ws_size, hipStream_t stream) {
    static int grid = 0;
    if (grid == 0) {
        if (n_in != 17 || in_sizes[0] != MR * DM || out_size != MR * DM || ws_size < WS_END) {
            fprintf(stderr, "kernel_launch: unexpected shapes (n_in %d, in0 %d, out %d, ws %zu); nothing launched\n", n_in, n_in > 0 ? in_sizes[0] : -1, out_size, ws_size); grid = -1; return; }
        int dev = 0, cus = 0, per_cu = 0;
        if (hipGetDevice(&dev) != hipSuccess || hipDeviceGetAttribute(&cus, hipDeviceAttributeMultiprocessorCount, dev) != hipSuccess) { grid = -1; return; }
        if (hipFuncSetAttribute((const void*)mk_fwd, hipFuncAttributeMaxDynamicSharedMemorySize, LDS_BYTES) != hipSuccess) { fprintf(stderr, "kernel_launch: hipFuncSetAttribute failed\n"); grid = -1; return; }
        if (hipOccupancyMaxActiveBlocksPerMultiprocessor(&per_cu, (const void*)mk_fwd, NWAVES * 64, LDS_BYTES) != hipSuccess || per_cu < 1) {
            fprintf(stderr, "kernel_launch: occupancy query reports %d workgroups per CU; nothing launched\n", per_cu); (void)hipGetLastError(); grid = -1; return; }
        grid = cus;
    }
    if (grid < 0) return;
    if (hipMemsetAsync((char*)d_ws + WS_CTL, 0, CTL_ZERO_BYTES, stream) != hipSuccess) return;
    Args a{};
    for (int i = 0; i < 17; ++i) a.in[i] = (const float*)d_in[i];
    a.out = (float*)d_out; a.ws = (unsigned char*)d_ws;
    for (int li = 0; li < N_LAUNCHES; ++li) {
        a.ph_lo = (N_LAUNCHES == PER_PHASE) ? li : 0; a.ph_hi = (N_LAUNCHES == PER_PHASE) ? li + 1 : PER_PHASE; a.li = li;
        hipLaunchKernelGGL(mk_fwd, dim3(grid), dim3(NWAVES * 64), LDS_BYTES, stream, a);
        if (hipPeekAtLastError() != hipSuccess) { fprintf(stderr, "kernel_launch: launch %d failed\n", li); break; }
    }
}
```

```cpp
#include <hip/hip_runtime.h>
#include <cstdio>
#include <cstdint>
#include <cmath>

#ifndef MK_N_LAUNCHES
#define MK_N_LAUNCHES 1
#endif

namespace pg8 {
#define PG8_LAS __attribute__((address_space(3)))
typedef unsigned short bf16_t;
typedef short bf16x8 __attribute__((ext_vector_type(8)));
typedef float f32x4 __attribute__((ext_vector_type(4)));
typedef unsigned u32x4 __attribute__((ext_vector_type(4)));
typedef unsigned u32x2 __attribute__((ext_vector_type(2)));
constexpr int BM = 256, BK = 64, HALF = 128, HTB = HALF * BK * 2  , STAGE_BYTES = 8 * HTB, NXCD = 8, WGM = 8;

__host__ __device__ __forceinline__ int lds_byte(int r, int c) { const int st = (r >> 4) * 2 + (c >> 5), rr = r & 15, cc = c & 31, ob = rr * 64 + cc * 2; return st * 1024 + (ob ^ (((ob >> 9) & 1) << 5)); }
__host__ __device__ __forceinline__ void stage_rc(int b, int& R, int& C) { const int st = b / 1024, sb = b % 1024, swz = sb ^ (((sb >> 9) & 1) << 5); R = (st >> 1) * 16 + swz / 64; C = (st & 1) * 32 + (swz % 64) / 2; }
__host__ __device__ __forceinline__ int perm32(int rho) { const int n = rho >> 4, i = rho & 15; return 8 * (i >> 2) + 4 * n + (i & 3); }

struct Unit { int pm, pn; };
struct Gemm { const bf16_t* A; const bf16_t* Bt; int M, N, K; };

struct StaticOrder {
    int nM, nN, nwg, G, c;
    __host__ __device__ void init(int M, int N, int G_, int c_) { nM = M / BM; nN = N / BM; nwg = nM * nN; G = G_; c = c_; }
    __host__ __device__ bool next(int i, Unit& u) const {
        const long L = (long)i * G + c; if (L >= nwg) return false;
        int wgid = (int)L; { const int q = nwg / NXCD, r = nwg % NXCD, xcd = wgid % NXCD, off = wgid / NXCD; wgid = (xcd < r ? xcd * (q + 1) : r * (q + 1) + (xcd - r) * q) + off; }
        const int nig = WGM * nN, gid = wgid / nig, fm = gid * WGM, gsz = (nM - fm) < WGM ? (nM - fm) : WGM;
        u.pm = fm + ((wgid % nig) % gsz); u.pn = (wgid % nig) / gsz; return true;
    }
    __device__ __forceinline__ void a_ready(const Unit&) const {}
    __device__ __forceinline__ void done(const Unit&) const {}
};
struct ListOrder {
    int n, c, pn0, pn1;
    __device__ bool next(int i, Unit& u) const { if (i != 0 || c >= n) return false; u.pm = 0; u.pn = (pn1 >= 0) ? (c == 0 ? pn0 : pn1) : (pn0 + c); return true; }
    __device__ __forceinline__ void a_ready(const Unit&) const {}
    __device__ __forceinline__ void done(const Unit&) const {}
};

__device__ __forceinline__ unsigned cvt_pk_bf16(float lo, float hi) { unsigned r; asm volatile("v_cvt_pk_bf16_f32 %0, %1, %2" : "=v"(r) : "v"(lo), "v"(hi)); return r; }
template <class Epi, class Sched, bool ALIGN_EPI = false, bool SP2 = false>
__device__ __forceinline__ void gemm_phase(PG8_LAS unsigned char* lds, const Gemm g, const Sched& S, const Epi& E) {
    const int tid = threadIdx.x, wid = __builtin_amdgcn_readfirstlane(tid >> 6), lane = tid & 63, wr = wid >> 2, wc = wid & 3, fr = lane & 15, fq = lane >> 4;
    const int K = g.K, nt = K / BK;
    unsigned voffA[2], voffB[2];
#pragma unroll
    for (int i = 0; i < 2; ++i) { int R, C; stage_rc(tid * 16 + i * 8192, R, C); const int Rb = Epi::PERM ? ((R & ~31) + perm32(R & 31)) : R;
        voffA[i] = (unsigned)(R * K + C) * 2u; voffB[i] = (unsigned)(Rb * K + C) * 2u; }
    const size_t kstep = (size_t)(BK * 2);
    const size_t hstep = (size_t)HALF * K * 2;
    const size_t tstep = 2 * hstep;
    const unsigned ldsw = (unsigned)wid * 1024u;
    const int aoff = lds_byte(wr * 64 + fr, fq * 8), boff = lds_byte(wc * 32 + fr, fq * 8);
#define PG8_SA(b, h) (((b) * 2 + (h)) * HTB)
#define PG8_SB(b, h) ((4 + (b) * 2 + (h)) * HTB)
#define PG8_STAGE(bufoff, gbase, voff) do { _Pragma("unroll") for (int _i = 0; _i < 2; ++_i) \
        __builtin_amdgcn_global_load_lds((const unsigned*)((const char*)(gbase) + (voff)[_i]), (PG8_LAS unsigned*)(lds + (bufoff) + ldsw + _i * 8192), 16, 0, 0); } while (0)
#define PG8_LDA(dst, b, h) do { _Pragma("unroll") for (int m = 0; m < 4; ++m) _Pragma("unroll") for (int k = 0; k < 2; ++k) dst[m][k] = *(const PG8_LAS bf16x8*)(lds + PG8_SA(b, h) + aoff + m * 2048 + k * 1024); } while (0)
#define PG8_LDB(dst, b, h) do { _Pragma("unroll") for (int n = 0; n < 2; ++n) _Pragma("unroll") for (int k = 0; k < 2; ++k) dst[n][k] = *(const PG8_LAS bf16x8*)(lds + PG8_SB(b, h) + boff + n * 2048 + k * 1024); } while (0)
#define PG8_MMA(ai, bj, At, Bt) do { __builtin_amdgcn_s_setprio(1); _Pragma("unroll") for (int m = 0; m < 4; ++m) _Pragma("unroll") for (int n = 0; n < 2; ++n) _Pragma("unroll") for (int k = 0; k < 2; ++k) \
        acc[ai][bj][m][n] = __builtin_amdgcn_mfma_f32_16x16x32_bf16(Bt[n][k], At[m][k], acc[ai][bj][m][n], 0, 0, 0); __builtin_amdgcn_s_setprio(0); } while (0)
#define PG8_WAIT_V(n) asm volatile("s_waitcnt vmcnt(" #n ")" ::: "memory")
#define PG8_WAIT_L(n) asm volatile("s_waitcnt lgkmcnt(" #n ")" ::: "memory")
#define PG8_BAR __builtin_amdgcn_s_barrier()
#define PG8_SCHED __builtin_amdgcn_sched_barrier(0)
    Unit cur, nxt; int ui = 0;
    if (!S.next(0, cur)) return;
    f32x4 acc[2][2][4][2];
#pragma unroll
    for (int a = 0; a < 2; ++a)
#pragma unroll
        for (int b = 0; b < 2; ++b)
#pragma unroll
            for (int m = 0; m < 4; ++m)
#pragma unroll
                for (int n = 0; n < 2; ++n) acc[a][b][m][n] = (f32x4){0.f, 0.f, 0.f, 0.f};
    bf16x8 At[4][2], B0[2][2], B1[2][2];
    const char* cA = (const char*)g.A + (size_t)cur.pm * tstep; const char* cB = (const char*)g.Bt + (size_t)cur.pn * tstep;
    S.a_ready(cur);
    if constexpr (SP2) {
        PG8_STAGE(PG8_SB(0, 0), cB, voffB); PG8_STAGE(PG8_SB(0, 1), cB + hstep, voffB); PG8_STAGE(PG8_SA(0, 0), cA, voffA); PG8_STAGE(PG8_SA(0, 1), cA + hstep, voffA);
        if (wr == 1) PG8_BAR;
        PG8_WAIT_V(2); PG8_BAR;
        PG8_STAGE(PG8_SB(1, 0), cB + kstep, voffB); PG8_STAGE(PG8_SA(1, 0), cA + kstep, voffA); PG8_STAGE(PG8_SB(1, 1), cB + hstep + kstep, voffB);
        PG8_WAIT_V(6); PG8_BAR;
    } else {
        PG8_STAGE(PG8_SB(0, 0), cB, voffB); PG8_STAGE(PG8_SA(0, 0), cA, voffA); PG8_STAGE(PG8_SB(0, 1), cB + hstep, voffB); PG8_STAGE(PG8_SA(0, 1), cA + hstep, voffA);
        if (wr == 1) PG8_BAR;
        PG8_WAIT_V(4); PG8_BAR;
        PG8_STAGE(PG8_SB(1, 0), cB + kstep, voffB); PG8_STAGE(PG8_SA(1, 0), cA + kstep, voffA); PG8_STAGE(PG8_SB(1, 1), cB + hstep + kstep, voffB);
        PG8_WAIT_V(6); PG8_BAR;
    }
    for (;;) {
        const bool has_next = S.next(ui + 1, nxt);
        const char* nA = has_next ? (const char*)g.A + (size_t)nxt.pm * tstep : cA; const char* nB = has_next ? (const char*)g.Bt + (size_t)nxt.pn * tstep : cB;
        for (int t = 0; t < nt; t += 2) {
            const bool last = (t == nt - 2);
            const char* a1 = cA + (size_t)(t + 1) * kstep;
            const char* a2 = last ? nA : cA + (size_t)(t + 2) * kstep; const char* b2 = last ? nB : cB + (size_t)(t + 2) * kstep;
            const char* a3 = a2 + kstep; const char* b3 = b2 + kstep;
            if (last && has_next) S.a_ready(nxt);
            if constexpr (SP2) {
            PG8_LDB(B0, 0, 0); PG8_LDB(B1, 0, 1); PG8_SCHED; PG8_LDA(At, 0, 0); PG8_STAGE(PG8_SA(1, 1), a1 + hstep, voffA);
            PG8_WAIT_V(8); PG8_WAIT_L(0); PG8_BAR; PG8_MMA(0, 0, At, B0); PG8_MMA(0, 1, At, B1); PG8_BAR; PG8_SCHED;
            PG8_LDA(At, 0, 1); PG8_STAGE(PG8_SB(0, 0), b2, voffB); PG8_STAGE(PG8_SB(0, 1), b2 + hstep, voffB); PG8_STAGE(PG8_SA(0, 0), a2, voffA);
            PG8_WAIT_V(8); PG8_WAIT_L(0); PG8_BAR; PG8_MMA(1, 0, At, B0); PG8_MMA(1, 1, At, B1); PG8_BAR; PG8_SCHED;
            PG8_LDB(B0, 1, 0); PG8_LDB(B1, 1, 1); PG8_SCHED; PG8_LDA(At, 1, 0); PG8_STAGE(PG8_SA(0, 1), a2 + hstep, voffA);
            PG8_WAIT_V(8); PG8_WAIT_L(0); PG8_BAR; PG8_MMA(0, 0, At, B0); PG8_MMA(0, 1, At, B1); PG8_BAR; PG8_SCHED;
            PG8_LDA(At, 1, 1); PG8_STAGE(PG8_SB(1, 0), b3, voffB); PG8_STAGE(PG8_SB(1, 1), b3 + hstep, voffB); PG8_STAGE(PG8_SA(1, 0), a3, voffA);
            PG8_WAIT_V(8); PG8_WAIT_L(0); PG8_BAR; PG8_MMA(1, 0, At, B0); PG8_MMA(1, 1, At, B1); PG8_BAR; PG8_SCHED;
            } else {
            PG8_LDB(B0, 0, 0); PG8_SCHED; PG8_LDA(At, 0, 0); PG8_STAGE(PG8_SA(1, 1), a1 + hstep, voffA);
            PG8_WAIT_L(8); PG8_BAR; PG8_WAIT_L(0); PG8_MMA(0, 0, At, B0); PG8_BAR; PG8_SCHED;
            PG8_LDB(B1, 0, 1); PG8_STAGE(PG8_SB(0, 0), b2, voffB);
            PG8_BAR; PG8_WAIT_L(0); PG8_MMA(0, 1, At, B1); PG8_BAR;
            PG8_LDA(At, 0, 1); PG8_STAGE(PG8_SA(0, 0), a2, voffA);
            PG8_BAR; PG8_WAIT_L(0); PG8_MMA(1, 0, At, B0); PG8_BAR; PG8_SCHED;
            PG8_STAGE(PG8_SB(0, 1), b2 + hstep, voffB);
            PG8_WAIT_V(6); PG8_BAR; PG8_MMA(1, 1, At, B1); PG8_BAR;
            PG8_LDB(B0, 1, 0); PG8_SCHED; PG8_LDA(At, 1, 0); PG8_STAGE(PG8_SA(0, 1), a2 + hstep, voffA);
            PG8_WAIT_L(8); PG8_BAR; PG8_WAIT_L(0); PG8_MMA(0, 0, At, B0); PG8_BAR; PG8_SCHED;
            PG8_LDB(B1, 1, 1); PG8_STAGE(PG8_SB(1, 0), b3, voffB);
            PG8_BAR; PG8_WAIT_L(0); PG8_MMA(0, 1, At, B1); PG8_BAR;
            PG8_LDA(At, 1, 1); PG8_STAGE(PG8_SA(1, 0), a3, voffA);
            PG8_BAR; PG8_WAIT_L(0); PG8_MMA(1, 0, At, B0); PG8_BAR; PG8_SCHED;
            PG8_STAGE(PG8_SB(1, 1), b3 + hstep, voffB);
            PG8_WAIT_V(6); PG8_BAR; PG8_MMA(1, 1, At, B1); PG8_BAR;
            }
        }
        if constexpr (ALIGN_EPI) { if (wr == 0) PG8_BAR; }
        if constexpr (!Epi::AFTER_DRAIN) { E(acc, cur, wr, wc, fr, fq); S.done(cur); }
        if (!has_next) break;
#pragma unroll
        for (int a = 0; a < 2; ++a)
#pragma unroll
            for (int b = 0; b < 2; ++b)
#pragma unroll
                for (int m = 0; m < 4; ++m)
#pragma unroll
                    for (int n = 0; n < 2; ++n) acc[a][b][m][n] = (f32x4){0.f, 0.f, 0.f, 0.f};
        cur = nxt; cA = nA; cB = nB; ++ui;
        if constexpr (ALIGN_EPI) { if (wr == 1) PG8_BAR; }
    }
    PG8_WAIT_V(0);
    if constexpr (!ALIGN_EPI) { if (wr == 0) PG8_BAR; }
    PG8_BAR;
    if constexpr (Epi::AFTER_DRAIN) { E.fused(acc, cur, wr, wc, fr, fq, lds, wid, lane); S.done(cur); }
#undef PG8_SA
#undef PG8_SB
#undef PG8_STAGE
#undef PG8_LDA
#undef PG8_LDB
#undef PG8_MMA
#undef PG8_WAIT_V
#undef PG8_WAIT_L
#undef PG8_BAR
#undef PG8_SCHED
}
}

constexpr int BATCH = 8, SEQ = 4096, DM = 1024, FF = 2816, NMETA = 16;
constexpr int MR = BATCH * SEQ;
constexpr int NKV = SEQ + 128;
constexpr int NIN = 3840;
constexpr float EPS = 1e-6f;
constexpr float LOG2E = 1.4426950408889634f;
constexpr float QSCALE = 0.125f * LOG2E;
constexpr float IDX_SCALE = 0.0625f;

namespace epi {
using pg8::f32x4; using pg8::u32x2; using pg8::Unit; using pg8::bf16_t; using pg8::cvt_pk_bf16;
typedef _Float16 f16x2 __attribute__((ext_vector_type(2)));

__device__ __forceinline__ float row_rs(const float* ssq, int row) {
    const f32x4* p = (const f32x4*)(ssq + (size_t)row * 16); const f32x4 a = p[0], b = p[1], c = p[2], d = p[3];
    const float s = (((a[0] + a[1]) + (a[2] + a[3])) + ((b[0] + b[1]) + (b[2] + b[3]))) + (((c[0] + c[1]) + (c[2] + c[3])) + ((d[0] + d[1]) + (d[2] + d[3])));
    return __builtin_amdgcn_rsqf(s * (1.0f / 1024.0f) + EPS);
}
__device__ __forceinline__ float sigmoidf_fast(float x) { return __builtin_amdgcn_rcpf(1.0f + __builtin_amdgcn_exp2f(-x * LOG2E)); }
__device__ __forceinline__ u32x2 pack4(const f32x4 v) { u32x2 w; w.x = cvt_pk_bf16(v[0], v[1]); w.y = cvt_pk_bf16(v[2], v[3]); return w; }
__device__ __forceinline__ unsigned pk_f16(float lo, float hi) { f16x2 h; h.x = (_Float16)lo; h.y = (_Float16)hi; return __builtin_bit_cast(unsigned, h); }
__device__ __forceinline__ u32x2 pack4h(const f32x4 v) { u32x2 w; w.x = pk_f16(v[0], v[1]); w.y = pk_f16(v[2], v[3]); return w; }
__device__ __forceinline__ f32x4 unpack4(const u32x2 w) { f32x4 v; v[0] = __uint_as_float(w.x << 16); v[1] = __uint_as_float(w.x & 0xffff0000u); v[2] = __uint_as_float(w.y << 16); v[3] = __uint_as_float(w.y & 0xffff0000u); return v; }


struct EpiGateUp {
    static constexpr bool PERM = false, AFTER_DRAIN = false;
    bf16_t* H; const float* ssq;
    __device__ __forceinline__ void operator()(const f32x4 (&acc)[2][2][4][2], const Unit& u, int wr, int wc, int fr, int fq) const {
#pragma unroll
        for (int ai = 0; ai < 2; ++ai)
#pragma unroll
            for (int m = 0; m < 4; ++m) {
                const int row = u.pm * 256 + ai * 128 + wr * 64 + m * 16 + fr; const float rs = row_rs(ssq, row);
                bf16_t* hp = H + (size_t)row * FF + u.pn * 128 + wc * 16 + fq * 4;
#pragma unroll
                for (int bj = 0; bj < 2; ++bj) { const f32x4 g = acc[ai][bj][m][0] * rs, up = acc[ai][bj][m][1] * rs; f32x4 h;
#pragma unroll
                    for (int e = 0; e < 4; ++e) h[e] = g[e] * sigmoidf_fast(g[e]) * up[e];
                    *(u32x2*)(hp + bj * 64) = pack4(h); }
            }
    }
};

struct EpiResid {
    static constexpr bool PERM = false, AFTER_DRAIN = false;
    const float* res; float* out; bf16_t* xb; float* ssq; float alpha;
    __device__ __forceinline__ void operator()(const f32x4 (&acc)[2][2][4][2], const Unit& u, int wr, int wc, int fr, int fq) const {
#pragma unroll
        for (int ai = 0; ai < 2; ++ai)
#pragma unroll
            for (int m = 0; m < 4; ++m) {
                const int row = u.pm * 256 + ai * 128 + wr * 64 + m * 16 + fr; const size_t off = (size_t)row * DM + u.pn * 256 + wc * 32 + fq * 4; float q = 0.f;
#pragma unroll
                for (int bj = 0; bj < 2; ++bj)
#pragma unroll
                    for (int n = 0; n < 2; ++n) { const size_t o2 = off + bj * 128 + n * 16; const f32x4 r = *(const f32x4*)(res + o2); const f32x4 o = r + acc[ai][bj][m][n] * alpha;
                        *(f32x4*)(out + o2) = o; q += (o[0] * o[0] + o[1] * o[1]) + (o[2] * o[2] + o[3] * o[3]);
                        if (xb) *(u32x2*)(xb + o2) = pack4(o); }
                q += __shfl_xor(q, 16); q += __shfl_xor(q, 32);
                if (fq == 0) ssq[(size_t)row * 16 + u.pn * 4 + wc] = q;
            }
    }
};

template <bool SECOND> struct EpiBranch {
    static constexpr bool PERM = false, AFTER_DRAIN = false;
    const bf16_t* sg; bf16_t* t1; bf16_t* outp;
    __device__ __forceinline__ void operator()(const f32x4 (&acc)[2][2][4][2], const Unit& u, int wr, int wc, int fr, int fq) const {
#pragma unroll
        for (int ai = 0; ai < 2; ++ai)
#pragma unroll
            for (int m = 0; m < 4; ++m) {
                const int row = u.pm * 256 + ai * 128 + wr * 64 + m * 16 + fr; const size_t off = (size_t)row * DM + u.pn * 256 + wc * 32 + fq * 4;
#pragma unroll
                for (int bj = 0; bj < 2; ++bj)
#pragma unroll
                    for (int n = 0; n < 2; ++n) { const size_t o2 = off + bj * 128 + n * 16; const f32x4 g = unpack4(*(const u32x2*)(sg + o2)); f32x4 o = g * acc[ai][bj][m][n];
                        if (SECOND) o = o + unpack4(*(const u32x2*)(t1 + o2));
                        *(u32x2*)((SECOND ? outp : t1) + o2) = pack4(o); }
            }
    }
};

struct EpiInProj {
    static constexpr bool PERM = false, AFTER_DRAIN = false;
    const float* ssq; const float* cosT; const float* sinT;
    bf16_t *QA, *KA, *VA, *QS, *KS, *VS, *SGA, *SGB; unsigned short *QI, *KI; float* WI; int meta;
    template <int MODE  > static __device__ __forceinline__ void rope_store(unsigned short* d, const f32x4 x1, const f32x4 x2, const f32x4 c, const f32x4 s, float sc) {
        const f32x4 o1 = (x1 * c - x2 * s) * sc, o2 = (x2 * c + x1 * s) * sc;
        if (MODE == 0) { *(u32x2*)d = pack4(o1); *(u32x2*)(d + 32) = pack4(o2); } else { *(u32x2*)d = pack4h(o1); *(u32x2*)(d + 32) = pack4h(o2); }
    }
    __device__ __forceinline__ void operator()(const f32x4 (&acc)[2][2][4][2], const Unit& u, int wr, int wc, int fr, int fq) const {
        const int pn = u.pn, g = wc & 1, hq = wc >> 1;
#pragma unroll
        for (int ai = 0; ai < 2; ++ai)
#pragma unroll
            for (int m = 0; m < 4; ++m) {
                const int rloc = ai * 128 + wr * 64 + m * 16 + fr, row = u.pm * 256 + rloc;
                if (meta && (ai | wr | m)) continue;
                const float rs = row_rs(ssq, row);
                int pos, krow; if (!meta) { const int b = row >> 12, t = row & 4095; pos = 16 + t; krow = b * NKV + 128 + t; } else { pos = rloc; krow = 112 + rloc; }
                const int nrep = meta ? BATCH : 1;
                if (pn < 7) {
                    const f32x4 c4 = *(const f32x4*)(cosT + pos * 32 + 16 * g + 4 * fq), s4 = *(const f32x4*)(sinT + pos * 32 + 16 * g + 4 * fq);
                    const int i0 = 16 * g + 4 * fq;
#pragma unroll
                    for (int bj = 0; bj < 2; ++bj) {
                        const f32x4 v0 = acc[ai][bj][m][0] * rs, v1 = acc[ai][bj][m][1] * rs;
                        if (pn <= 1) { if (!meta) rope_store<0>(QA + (size_t)row * 512 + (pn * 4 + bj * 2 + hq) * 64 + i0, v0, v1, c4, s4, QSCALE); }
                        else if (pn == 3) { if (!meta) rope_store<1>(QI + (size_t)row * 256 + (bj * 2 + hq) * 64 + i0, v0, v1, c4, s4, 1.0f); }
                        else if (pn <= 5 && pn >= 4) { if (!meta) rope_store<0>(QS + (size_t)row * 512 + ((pn - 4) * 4 + bj * 2 + hq) * 64 + i0, v0, v1, c4, s4, QSCALE); }
                        else if (pn == 2) {
                            for (int rep = 0; rep < nrep; ++rep) { const size_t kr = (size_t)krow + (size_t)rep * NKV;
                                if (bj == 0) { if (wc < 2) rope_store<0>(KA + kr * 64 + i0, v0, v1, c4, s4, 1.0f);
                                               else { bf16_t* d = VA + kr * 64 + 32 * (wc - 2) + 4 * fq; *(u32x2*)d = pack4(v0); *(u32x2*)(d + 16) = pack4(v1); } }
                                else if (wc < 2) rope_store<1>(KI + kr * 64 + i0, v0, v1, c4, s4, 1.0f); }
                            if (bj == 1 && wc == 2 && fq == 0 && !meta) *(f32x4*)(WI + (size_t)row * 4) = v0 * IDX_SCALE;
                        } else {
                            for (int rep = 0; rep < nrep; ++rep) { const size_t kr = (size_t)krow + (size_t)rep * NKV;
                                if (bj == 0) rope_store<0>(KS + kr * 128 + hq * 64 + i0, v0, v1, c4, s4, 1.0f);
                                else { bf16_t* d = VS + kr * 128 + 32 * wc + 4 * fq; *(u32x2*)d = pack4(v0); *(u32x2*)(d + 16) = pack4(v1); } }
                        }
                    }
                } else if (!meta) {
                    bf16_t* d = (pn < 11 ? SGA + (size_t)(pn - 7) * 256 : SGB + (size_t)(pn - 11) * 256) + (size_t)row * DM + wc * 32 + fq * 4;
#pragma unroll
                    for (int bj = 0; bj < 2; ++bj)
#pragma unroll
                        for (int n = 0; n < 2; ++n) { const f32x4 v = acc[ai][bj][m][n] * rs; f32x4 o;
#pragma unroll
                            for (int e = 0; e < 4; ++e) o[e] = sigmoidf_fast(v[e]);
                            *(u32x2*)(d + bj * 128 + n * 16) = pack4(o); }
                }
            }
    }
};
}

namespace att {
#define ALAS __attribute__((address_space(3)))
typedef _Float16 f16x8 __attribute__((ext_vector_type(8)));
typedef short bf16x8 __attribute__((ext_vector_type(8)));
typedef short s16x4 __attribute__((ext_vector_type(4)));
typedef float f32x16 __attribute__((ext_vector_type(16)));
typedef float f32x4 __attribute__((ext_vector_type(4)));
typedef unsigned u32x4 __attribute__((ext_vector_type(4)));
typedef unsigned u32x2 __attribute__((ext_vector_type(2)));
typedef unsigned short u16;

constexpr int L_MASK = 131072, MASK_W = 136;
constexpr int L_QINFO = L_MASK + 32 * MASK_W * 4;
constexpr int L_WSF = L_QINFO + 512;
constexpr int L_END = L_WSF + 8 * 64 * 4;
constexpr int L_KBUF = 0, L_VBUF = 32768, L_OST = 65536;
constexpr int CAND_CAP = 512;

__device__ __forceinline__ int crow(int r, int hi) { return (r & 3) + 8 * (r >> 2) + 4 * hi; }
__device__ __forceinline__ unsigned swap_or(unsigned w) { auto rr = __builtin_amdgcn_permlane32_swap(w, w, false, false); return rr[0] | rr[1]; }
__device__ __forceinline__ float swap_max(float m) { auto rr = __builtin_amdgcn_permlane32_swap(__float_as_uint(m), __float_as_uint(m), false, false); return fmaxf(__uint_as_float(rr[0]), __uint_as_float(rr[1])); }
__device__ __forceinline__ float swap_add(float m) { auto rr = __builtin_amdgcn_permlane32_swap(__float_as_uint(m), __float_as_uint(m), false, false); return __uint_as_float(rr[0]) + __uint_as_float(rr[1]); }

__device__ __forceinline__ void select_unit(ALAS unsigned char* lds, int b, int qt, const u16* QI, const u16* KI, const float* WI, unsigned* err) {
    const int tid = threadIdx.x, lane = tid & 63, r32 = lane & 31, hi = lane >> 5; const int wid = __builtin_amdgcn_readfirstlane(tid >> 6);
    ALAS unsigned* hist = (ALAS unsigned*)lds;
    ALAS unsigned* maskw = (ALAS unsigned*)(lds + L_MASK);
    ALAS unsigned* qinfo = (ALAS unsigned*)(lds + L_QINFO);
    ALAS u32x2* cand = (ALAS u32x2*)lds;
    { ALAS u32x4* z = (ALAS u32x4*)lds; const u32x4 zero = {0u, 0u, 0u, 0u};
      for (int i = tid; i < (L_WSF / 16); i += 512) z[i] = zero; }
    const size_t row0 = (size_t)b * SEQ + 32 * qt;
    f16x8 qf[4][4];
#pragma unroll
    for (int h = 0; h < 4; ++h)
#pragma unroll
        for (int ks = 0; ks < 4; ++ks) qf[h][ks] = *(const f16x8*)(QI + (row0 + r32) * 256 + h * 64 + ks * 16 + hi * 8);
    const f32x4 w4 = *(const f32x4*)(WI + (row0 + r32) * 4);
    const int sq = 128 + 32 * qt + r32;
    __syncthreads();
    for (int pass = 0; pass < 2; ++pass) {
        unsigned binstar = 0u; if (pass) binstar = qinfo[r32 * 4 + 0];
        for (int kb = 3 + wid; kb <= 4 + qt; kb += 8) {
            const u16* kp = KI + ((size_t)b * NKV + kb * 32 + r32) * 64 + hi * 8;
            f16x8 kf[4];
#pragma unroll
            for (int ks = 0; ks < 4; ++ks) kf[ks] = *(const f16x8*)(kp + ks * 16);
            f32x16 a0 = {}, a1 = {}, a2 = {}, a3 = {};
#pragma unroll
            for (int ks = 0; ks < 4; ++ks) {
                a0 = __builtin_amdgcn_mfma_f32_32x32x16_f16(kf[ks], qf[0][ks], a0, 0, 0, 0);
                a1 = __builtin_amdgcn_mfma_f32_32x32x16_f16(kf[ks], qf[1][ks], a1, 0, 0, 0);
                a2 = __builtin_amdgcn_mfma_f32_32x32x16_f16(kf[ks], qf[2][ks], a2, 0, 0, 0);
                a3 = __builtin_amdgcn_mfma_f32_32x32x16_f16(kf[ks], qf[3][ks], a3, 0, 0, 0);
            }
            unsigned wpart = 0u;
#pragma unroll
            for (int r = 0; r < 16; ++r) {
                float sc = w4[0] * fmaxf(a0[r], 0.f); sc = fmaf(w4[1], fmaxf(a1[r], 0.f), sc); sc = fmaf(w4[2], fmaxf(a2[r], 0.f), sc); sc = fmaf(w4[3], fmaxf(a3[r], 0.f), sc);
                sc += 0.0f;
                const int s = kb * 32 + crow(r, hi); const bool valid = (s >= 112) && (s <= sq);
                const unsigned bits = __float_as_uint(sc);
                int idx = (int)((bits & 0x7fffffffu) >> 18) - 3551; idx = idx < 0 ? 0 : (idx > 705 ? 705 : idx);
                const unsigned bin = (bits >> 31) ? (unsigned)(1023 - idx) : (unsigned)(1024 + idx);
                if (pass == 0) {
                    if (valid) __hip_atomic_fetch_add(hist + r32 * 1024 + (bin >> 1), 1u << ((bin & 1u) * 16u), __ATOMIC_RELAXED, __HIP_MEMORY_SCOPE_WORKGROUP);
                } else {
                    if (valid && bin > binstar) wpart |= 1u << crow(r, 0);
                    if (valid && bin == binstar) {
                        const unsigned slot = __hip_atomic_fetch_add(qinfo + r32 * 4 + 2, 1u, __ATOMIC_RELAXED, __HIP_MEMORY_SCOPE_WORKGROUP);
                        if (slot < (unsigned)CAND_CAP) { u32x2 e; e.x = bits ^ ((unsigned)((int)bits >> 31) | 0x80000000u); e.y = (unsigned)s; cand[r32 * CAND_CAP + slot] = e; }
                    }
                }
            }
            if (pass) { const unsigned word = swap_or(wpart << (4 * hi)); if (hi == 0) maskw[r32 * MASK_W + kb] = word; }
        }
        __syncthreads();
        if (pass == 0) {
            for (int qq = 0; qq < 4; ++qq) {
                const int q = wid * 4 + qq; int kq = 32 * qt + q + 17; kq = kq > 256 ? 256 : kq;
                const ALAS u32x4* hp = (const ALAS u32x4*)(hist + q * 1024 + lane * 16);
                unsigned sum = 0u;
#pragma unroll
                for (int i = 0; i < 4; ++i) { const u32x4 w = hp[i]; sum += ((w.x & 0xffffu) + (w.x >> 16)) + ((w.y & 0xffffu) + (w.y >> 16)) + ((w.z & 0xffffu) + (w.z >> 16)) + ((w.w & 0xffffu) + (w.w >> 16)); }
                unsigned I = sum;
#pragma unroll
                for (int o = 1; o < 64; o <<= 1) { const unsigned y = __shfl_down(I, o); if (lane + o < 64) I += y; }
                const unsigned above = I - sum; const bool hit = (I >= (unsigned)kq) && (above < (unsigned)kq);
                const unsigned long long bal = __ballot(hit);
                const int lstar = bal ? (__ffsll((long long)bal) - 1) : 0;
                const unsigned aboveS = __shfl(above, lstar);
                unsigned c = 0u; if (lane < 32) { const unsigned wv = hist[q * 1024 + lstar * 16 + (lane >> 1)]; c = (lane & 1) ? (wv >> 16) : (wv & 0xffffu); }
                unsigned I2 = c;
#pragma unroll
                for (int o = 1; o < 32; o <<= 1) { const unsigned y = __shfl_down(I2, o); if (lane + o < 64) I2 += y; }
                const bool hit2 = (lane < 32) && (aboveS + I2 >= (unsigned)kq) && (aboveS + I2 - c < (unsigned)kq);
                if (hit2) { qinfo[q * 4 + 0] = (unsigned)(lstar * 32 + lane); qinfo[q * 4 + 1] = aboveS + I2 - c; qinfo[q * 4 + 3] = (unsigned)kq; }
            }
            __syncthreads();
        }
    }
    for (int qq = 0; qq < 4; ++qq) {
        const int q = wid * 4 + qq; const unsigned nraw = qinfo[q * 4 + 2]; const int n = nraw > (unsigned)CAND_CAP ? CAND_CAP : (int)nraw;
        const int rneed = (int)qinfo[q * 4 + 3] - (int)qinfo[q * 4 + 1];
        if (nraw > (unsigned)CAND_CAP && lane == 0) atomicOr(err, 2u);
        for (int i0 = 0; i0 < n; i0 += 64) {
            const int i = i0 + lane; const bool act = i < n; u32x2 me = {0u, 0u}; if (act) me = cand[q * CAND_CAP + i];
            int rank = 0;
            for (int j = 0; j < n; ++j) { const u32x2 o = cand[q * CAND_CAP + j]; rank += ((o.x > me.x) || (o.x == me.x && o.y < me.y)) ? 1 : 0; }
            if (act && rank < rneed) __hip_atomic_fetch_or(maskw + q * MASK_W + (me.y >> 5), 1u << (me.y & 31u), __ATOMIC_RELAXED, __HIP_MEMORY_SCOPE_WORKGROUP);
        }
    }
    __syncthreads();
}

__device__ __forceinline__ void pv(f32x16* o, int vb, bf16x8 pa0, bf16x8 pa1, bf16x8 pa2, bf16x8 pa3) {
#pragma unroll
    for (int d0 = 0; d0 < 2; ++d0) { s16x4 lo[4], hi[4];
#pragma unroll
        for (int ks = 0; ks < 4; ++ks) {
            asm volatile("ds_read_b64_tr_b16 %0,%1 offset:%c2" : "=&v"(lo[ks]) : "v"(vb), "i"(d0 * 4096 + ks * 1024) : "memory");
            asm volatile("ds_read_b64_tr_b16 %0,%1 offset:%c2" : "=&v"(hi[ks]) : "v"(vb), "i"(d0 * 4096 + ks * 1024 + 512) : "memory"); }
        asm volatile("s_waitcnt lgkmcnt(0)" ::: "memory"); __builtin_amdgcn_sched_barrier(0);
#define ATT_PK(k) (bf16x8){lo[k][0], lo[k][1], lo[k][2], lo[k][3], hi[k][0], hi[k][1], hi[k][2], hi[k][3]}
        o[d0] = __builtin_amdgcn_mfma_f32_32x32x16_bf16(pa0, ATT_PK(0), o[d0], 0, 0, 0);
        o[d0] = __builtin_amdgcn_mfma_f32_32x32x16_bf16(pa1, ATT_PK(1), o[d0], 0, 0, 0);
        o[d0] = __builtin_amdgcn_mfma_f32_32x32x16_bf16(pa2, ATT_PK(2), o[d0], 0, 0, 0);
        o[d0] = __builtin_amdgcn_mfma_f32_32x32x16_bf16(pa3, ATT_PK(3), o[d0], 0, 0, 0);
#undef ATT_PK
    }
}

template <bool SWA> __device__ __forceinline__ void attn_unit(ALAS unsigned char* lds, int b, int qt, const u16* Q, const u16* K, const u16* V, u16* O, float sink2) {
    constexpr int KP = SWA ? 128 : 64, NH = SWA ? 2 : 1;
    const int tid = threadIdx.x, lane = tid & 63, r32 = lane & 31, hi = lane >> 5; const int wid = __builtin_amdgcn_readfirstlane(tid >> 6);
    const int kvh = SWA ? (wid >> 2) : 0;
    const size_t row0 = (size_t)b * SEQ + 32 * qt;
    bf16x8 qr[4];
#pragma unroll
    for (int d0 = 0; d0 < 4; ++d0) qr[d0] = *(const bf16x8*)(Q + (row0 + r32) * 512 + wid * 64 + d0 * 16 + hi * 8);
    const int sq = 128 + 32 * qt + r32;
    const int j_lo = SWA ? (qt >> 1) : 1, j_hi = (qt >> 1) + 2;
    const u16* Kb = K + (size_t)b * NKV * KP; const u16* Vb = V + (size_t)b * NKV * KP;
    const int skey = tid & 63, schunk = tid >> 6;
    const int vrow = 16 * ((tid >> 6) & 3) + (lane >> 2), vdh = tid >> 8, vpc = lane & 3;
    ALAS const unsigned* maskw = (ALAS const unsigned*)(lds + L_MASK) + r32 * MASK_W;
    ALAS float* wsf = (ALAS float*)(lds + L_WSF) + wid * 64;
    u32x4 kreg[NH], vreg[NH];
#define ATT_LOAD(j) do { _Pragma("unroll") for (int hd = 0; hd < NH; ++hd) { \
        kreg[hd] = *(const u32x4*)(Kb + (size_t)(64 * (j) + skey) * KP + hd * 64 + schunk * 8); \
        vreg[hd] = *(const u32x4*)(Vb + (size_t)(64 * (j) + vrow) * KP + hd * 64 + vdh * 32 + vpc * 8); } } while (0)
#define ATT_STORE(buf) do { _Pragma("unroll") for (int hd = 0; hd < NH; ++hd) { \
        *(ALAS u32x4*)(lds + L_KBUF + (buf) * 16384 + hd * 8192 + tid * 16) = kreg[hd]; \
        *(ALAS u32x4*)(lds + L_VBUF + (buf) * 16384 + hd * 8192 + tid * 16) = vreg[hd]; } } while (0)
    float m_run = SWA ? sink2 : -1.0e4f, lsum = (SWA && hi == 0) ? 1.0f : 0.0f;
    f32x16 o[2]; o[0] = f32x16{}; o[1] = f32x16{};
    ATT_LOAD(j_lo); ATT_STORE(0);
    __syncthreads();
    int cur = 0;
    for (int j = j_lo; j <= j_hi; ++j) {
        const bool more = j < j_hi;
        if (more) ATT_LOAD(j + 1);
        f32x16 p0 = f32x16{}, p1 = f32x16{};
        { ALAS const unsigned char* kb = lds + L_KBUF + cur * 16384 + kvh * 8192 + hi * 1024 + r32 * 16;
#pragma unroll
          for (int d0 = 0; d0 < 4; ++d0) { const bf16x8 b0 = *(ALAS const bf16x8*)(kb + d0 * 2048), b1 = *(ALAS const bf16x8*)(kb + d0 * 2048 + 512);
              p0 = __builtin_amdgcn_mfma_f32_32x32x16_bf16(b0, qr[d0], p0, 0, 0, 0); p1 = __builtin_amdgcn_mfma_f32_32x32x16_bf16(b1, qr[d0], p1, 0, 0, 0); } }
        unsigned w0, w1;
        if (SWA) {
            const int los = (sq - 127) > 112 ? (sq - 127) : 112;
            { const int base = 64 * j; const int a = los - base, e = sq - base; const int a2 = a < 0 ? 0 : a, e2 = e > 31 ? 31 : e;
              w0 = (a2 > 31 || e2 < 0 || a2 > e2) ? 0u : ((0xffffffffu >> (31 - e2)) & (0xffffffffu << a2)); }
            { const int base = 64 * j + 32; const int a = los - base, e = sq - base; const int a2 = a < 0 ? 0 : a, e2 = e > 31 ? 31 : e;
              w1 = (a2 > 31 || e2 < 0 || a2 > e2) ? 0u : ((0xffffffffu >> (31 - e2)) & (0xffffffffu << a2)); }
        } else { w0 = maskw[2 * j]; w1 = maskw[2 * j + 1]; }
        w0 >>= 4 * hi; w1 >>= 4 * hi;
        const float NEG = -INFINITY;
#pragma unroll
        for (int r = 0; r < 16; ++r) { p0[r] = ((w0 >> crow(r, 0)) & 1u) ? p0[r] : NEG; p1[r] = ((w1 >> crow(r, 0)) & 1u) ? p1[r] : NEG; }
        float tm = fmaxf(p0[0], p1[0]);
#pragma unroll
        for (int r = 1; r < 16; ++r) tm = fmaxf(tm, fmaxf(p0[r], p1[r]));
        tm = swap_max(tm);
        if (__any(tm > m_run)) {
            const float mn = fmaxf(m_run, tm), alpha = __builtin_amdgcn_exp2f(m_run - mn);
            lsum *= alpha; m_run = mn;
            if (hi == 0) wsf[r32] = alpha;
            asm volatile("s_waitcnt lgkmcnt(0)" ::: "memory");
#pragma unroll
            for (int r = 0; r < 16; ++r) { const float f = wsf[crow(r, hi)]; o[0][r] *= f; o[1][r] *= f; }
        }
        float sacc = 0.f;
#pragma unroll
        for (int r = 0; r < 16; ++r) { p0[r] = __builtin_amdgcn_exp2f(p0[r] - m_run); p1[r] = __builtin_amdgcn_exp2f(p1[r] - m_run); sacc += p0[r] + p1[r]; }
        lsum += sacc;
        u32x4 pw0, pw1, pw2, pw3;
#define ATT_PKW(P, B) pg8::cvt_pk_bf16(P[B], P[B + 1])
        pw0 = (u32x4){ATT_PKW(p0, 0), ATT_PKW(p0, 2), ATT_PKW(p0, 4), ATT_PKW(p0, 6)}; pw1 = (u32x4){ATT_PKW(p0, 8), ATT_PKW(p0, 10), ATT_PKW(p0, 12), ATT_PKW(p0, 14)};
        pw2 = (u32x4){ATT_PKW(p1, 0), ATT_PKW(p1, 2), ATT_PKW(p1, 4), ATT_PKW(p1, 6)}; pw3 = (u32x4){ATT_PKW(p1, 8), ATT_PKW(p1, 10), ATT_PKW(p1, 12), ATT_PKW(p1, 14)};
#undef ATT_PKW
        const int vb = (int)(size_t)(lds + L_VBUF + cur * 16384 + kvh * 8192) + ((lane >> 4) & 1) * 32 + (lane & 3) * 8 + (4 * hi + ((lane & 15) >> 2)) * 64;
        pv(o, vb, __builtin_bit_cast(bf16x8, pw0), __builtin_bit_cast(bf16x8, pw1), __builtin_bit_cast(bf16x8, pw2), __builtin_bit_cast(bf16x8, pw3));
        if (more) ATT_STORE(cur ^ 1);
        __syncthreads();
        cur ^= 1;
    }
#undef ATT_LOAD
#undef ATT_STORE
    lsum = swap_add(lsum);
    if (hi == 0) wsf[32 + r32] = lsum;
    asm volatile("s_waitcnt lgkmcnt(0)" ::: "memory");
    ALAS u16* stg = (ALAS u16*)(lds + L_OST + wid * 4096);
#pragma unroll
    for (int r = 0; r < 16; ++r) { const int orow = crow(r, hi); const float rl = __builtin_amdgcn_rcpf(wsf[32 + orow]);
#pragma unroll
        for (int d0 = 0; d0 < 2; ++d0) stg[orow * 64 + d0 * 32 + r32] = (u16)(pg8::cvt_pk_bf16(o[d0][r] * rl, 0.f) & 0xffffu); }
    asm volatile("s_waitcnt lgkmcnt(0)" ::: "memory");
#pragma unroll
    for (int i = 0; i < 4; ++i) { const int row = i * 8 + (lane >> 3), ch = lane & 7; const u32x4 v = *(ALAS const u32x4*)(stg + row * 64 + ch * 8);
        *(u32x4*)(O + (row0 + row) * 512 + wid * 64 + ch * 8) = v; }
    asm volatile("s_waitcnt lgkmcnt(0)" ::: "memory");
}
}

constexpr int NWAVES = 8;
constexpr int N_LAUNCHES = MK_N_LAUNCHES;
constexpr int PER_PHASE = 10;

constexpr size_t MiB = 1u << 20;
constexpr size_t WS_CTL = 0, CTL_ZERO_BYTES = 1 * MiB;
constexpr size_t WS_W1T = 1 * MiB, WS_WD1T = 12 * MiB, WS_WINT = 18 * MiB, WS_WBST = 26 * MiB, WS_WBWT = 27 * MiB, WS_WOUTT = 28 * MiB, WS_W2T = 30 * MiB, WS_WD2T = 41 * MiB;
constexpr size_t WS_COS = 47 * MiB, WS_SIN = 48 * MiB;
constexpr size_t WS_SSQ0 = 49 * MiB, WS_SSQ1 = 51 * MiB, WS_SSQ2 = 53 * MiB, WS_SSQ3 = 55 * MiB;
constexpr size_t WS_WI = 57 * MiB, WS_KA = 58 * MiB, WS_VA = 63 * MiB, WS_KI = 68 * MiB, WS_KS = 73 * MiB, WS_VS = 82 * MiB;
constexpr size_t WS_AM = 91 * MiB, WS_SSQM0 = 91 * MiB + 512 * 1024, WS_SSQM1 = 91 * MiB + 768 * 1024, WS_HM = 92 * MiB, WS_XBM = 93 * MiB + 512 * 1024, WS_H0M = 94 * MiB, WS_H1M = 95 * MiB;
constexpr size_t WS_XB = 96 * MiB;
constexpr size_t WS_HFF = 160 * MiB;
constexpr size_t WS_QA = 160 * MiB, WS_QS = 192 * MiB, WS_QI = 224 * MiB, WS_OSP = 240 * MiB, WS_OSW = 272 * MiB, WS_MERGED = 160 * MiB;
constexpr size_t WS_SGA = 336 * MiB, WS_SGB = 400 * MiB, WS_END = 464 * MiB;
constexpr int CW_ERR = 0;
constexpr int CW_BAR = 4096;

constexpr int RING_OFF = 0, RING_BYTES = 131072;
constexpr int LDSCTL_OFF = 151552, MISC_OFF = LDSCTL_OFF + 320;
constexpr int LDS_BYTES = 155648;
static_assert(att::L_END <= LDSCTL_OFF && MISC_OFF + 128 <= LDS_BYTES, "LDS map");

#define GAS __attribute__((address_space(1)))
#define LAS __attribute__((address_space(3)))
typedef unsigned short bf16;
typedef unsigned v4u __attribute__((ext_vector_type(4)));
typedef float f32x4 __attribute__((ext_vector_type(4)));
typedef GAS unsigned gu32;
#define RLX_AGENT __ATOMIC_RELAXED, __HIP_MEMORY_SCOPE_AGENT
#define LDS_WAIT() asm volatile("s_waitcnt lgkmcnt(0)" ::: "memory")
__device__ __forceinline__ unsigned f2bf(float f) { unsigned u = __builtin_bit_cast(unsigned, f); return (u + 0x7fffu + ((u >> 16) & 1u)) >> 16; }
__device__ __forceinline__ unsigned pk2(float lo, float hi) { return f2bf(lo) | (f2bf(hi) << 16); }
#define XB_TMO      128
#define XB_XCNT(j)  (256  + 64 * (j))
#define XB_XSUB(j)  (1280 + 64 * (j))
#define XB_XGEN(j)  (2304 + 64 * (j))
#define XB_TOP      3328
#define XB_TOPGEN   3392
#define XCD_BAR_WORDS 3456
#define XB_SPIN_CAP (1u << 22)

__device__ __forceinline__ unsigned xb_ld(unsigned* p)              { return __hip_atomic_load(p, __ATOMIC_RELAXED, __HIP_MEMORY_SCOPE_AGENT); }
__device__ __forceinline__ unsigned xb_add(unsigned* p, unsigned v) { return __hip_atomic_fetch_add(p, v, __ATOMIC_RELAXED, __HIP_MEMORY_SCOPE_AGENT); }
__device__ __forceinline__ unsigned xb_xcc_id() { return (unsigned)__builtin_amdgcn_s_getreg((3 << 11) | 20) & 0xFu; }
#define XB_SPIN(cond, bar) do { unsigned _sp = 0; while (cond) { __builtin_amdgcn_s_sleep(1); \
    if ((++_sp & 255u) == 0u) { if (xb_ld(&(bar)[XB_TMO])) break; if (_sp > XB_SPIN_CAP) { atomicAdd(&(bar)[XB_TMO], 1u); break; } } } } while (0)

struct XcdBarrier {
    unsigned* bar; unsigned x;
    volatile LAS unsigned* st;
};

__device__ __forceinline__ XcdBarrier xcd_barrier_post(unsigned* bar, volatile LAS unsigned* st) {
    XcdBarrier b; b.bar = bar; b.x = xb_xcc_id(); b.st = st;
    if (threadIdx.x == 0) (void)xb_add(&bar[XB_XCNT(b.x)], 1u);
    return b;
}
__device__ __forceinline__ void xcd_barrier_complete(unsigned* bar, unsigned x, unsigned& nloc, unsigned& nx) {
    const unsigned G = gridDim.x * gridDim.y * gridDim.z;
    unsigned sum, cnt, mine, sp = 0u;
    for (;;) {
        sum = 0u; cnt = 0u; mine = 0u;
#pragma unroll
        for (unsigned j = 0; j < 16; ++j) { const unsigned c = xb_ld(&bar[XB_XCNT(j)]); sum += c; cnt += (c > 0u) ? 1u : 0u; mine = (j == x) ? c : mine; }
        if (sum == G) break;
        __builtin_amdgcn_s_sleep(1);
        if ((++sp & 255u) == 0u) { if (xb_ld(&bar[XB_TMO])) break; if (sp > XB_SPIN_CAP) { atomicAdd(&bar[XB_TMO], 1u); break; } }
    }
    nloc = mine > 0u ? mine : 1u; nx = cnt > 0u ? cnt : 1u;
}

__device__ __forceinline__ void xcd_barrier(const XcdBarrier& b) {
    asm volatile("s_waitcnt vmcnt(0)" ::: "memory");
    __syncthreads();
    if (threadIdx.x == 0) {
        unsigned* bar = b.bar;
        __builtin_amdgcn_s_waitcnt(0);
        unsigned nloc = b.st[0], nx = b.st[1];
        if (nloc == 0u) { xcd_barrier_complete(bar, b.x, nloc, nx); b.st[0] = nloc; b.st[1] = nx; }
        const unsigned old = xb_add(&bar[XB_XSUB(b.x)], 1u);
        const unsigned gen = old / nloc;
        if (old + 1u == (gen + 1u) * nloc) {
            __builtin_amdgcn_fence(__ATOMIC_RELEASE, "agent");
            asm volatile("s_waitcnt vmcnt(0)" ::: "memory");
            const unsigned og = xb_add(&bar[XB_TOP], 1u);
            const unsigned tg = og / nx;
            if (og + 1u == (tg + 1u) * nx) xb_add(&bar[XB_TOPGEN], 1u);
            else XB_SPIN(xb_ld(&bar[XB_TOPGEN]) == tg, bar);
            __builtin_amdgcn_fence(__ATOMIC_ACQUIRE, "agent");
            xb_add(&bar[XB_XGEN(b.x)], 1u);
            asm volatile("s_waitcnt vmcnt(0)" ::: "memory");
        } else {
            XB_SPIN(xb_ld(&bar[XB_XGEN(b.x)]) == gen, bar);
            __builtin_amdgcn_fence(__ATOMIC_ACQUIRE, "agent");
            asm volatile("s_waitcnt vmcnt(0)" ::: "memory");
        }
    }
    __syncthreads();
}

__device__ __forceinline__ float wave_sum(float v) {
#pragma unroll
    for (int o = 1; o < 64; o <<= 1) v += __shfl_xor(v, o);
    return v;
}
__device__ __forceinline__ int ropepos(int w) { const int i = w & 31, half = w >> 5; return 32 * (i >> 4) + 16 * half + (i & 15); }
struct MapIdent { int off; __device__ __forceinline__ int operator()(int n) const { return off + n; } };
struct MapGateUp { int type; __device__ __forceinline__ int operator()(int j) const { return (j >> 4) * 32 + type * 16 + (j & 15); } };
struct MapInProj { __device__ __forceinline__ int operator()(int n) const {
    if (n < 512) return (n >> 6) * 64 + ropepos(n & 63);
    if (n < 576) return 512 + ropepos(n - 512);
    if (n < 640) return 576 + (n - 576);
    if (n < 896) { const int m = n - 640; return 768 + (m >> 6) * 64 + ropepos(m & 63); }
    if (n < 960) return 640 + ropepos(n - 896);
    if (n < 964) return 704 + (n - 960);
    if (n < 1476) { const int m = n - 964; return 1024 + (m >> 6) * 64 + ropepos(m & 63); }
    if (n < 1604) { const int m = n - 1476; return 1536 + (m >> 6) * 64 + ropepos(m & 63); }
    if (n < 1732) return 1664 + (n - 1604);
    if (n < 2756) return 1792 + (n - 1732);
    return 2816 + (n - 2756);
} };
template <class Map> __device__ __forceinline__ void transpose_item(const float* W, int K, int N, const float* gain, bf16* WT, const Map& map, LAS float* scr, int item, int lane) {
    const int nblk = (N + 31) / 32, kb = item / nblk, nb = item % nblk, k0 = 64 * kb, n0 = 32 * nb, n = n0 + (lane & 31);
#pragma unroll 8
    for (int i = 0; i < 32; ++i) { const int kk = 2 * i + (lane >> 5); float v = 0.f; if (n < N) { v = W[(size_t)(k0 + kk) * N + n]; if (gain) v *= gain[k0 + kk]; } scr[kk * 33 + (lane & 31)] = v; }
    LDS_WAIT(); asm volatile("" ::: "memory");
    const int c = lane & 7;
#pragma unroll
    for (int j = 0; j < 4; ++j) { const int nl = (lane >> 3) + 8 * j; if (n0 + nl < N) { const LAS float* s = scr + (8 * c) * 33 + nl;
        v4u o; o.x = pk2(s[0 * 33], s[1 * 33]); o.y = pk2(s[2 * 33], s[3 * 33]); o.z = pk2(s[4 * 33], s[5 * 33]); o.w = pk2(s[6 * 33], s[7 * 33]);
        *(v4u*)(WT + (size_t)map(n0 + nl) * K + k0 + 8 * c) = o; } }
    LDS_WAIT(); asm volatile("" ::: "memory");
}
__device__ __forceinline__ void row_to_bf16_ssq(const float* xrow, bf16* orow, float* frow, float* ssqrow, int lane, bool zero) {
    const f32x4* xr = (const f32x4*)xrow + lane; f32x4 v[4]; float s = 0.f;
#pragma unroll
    for (int j = 0; j < 4; ++j) { v[j] = zero ? (f32x4){0.f, 0.f, 0.f, 0.f} : xr[64 * j]; s += (v[j][0] * v[j][0] + v[j][1] * v[j][1]) + (v[j][2] * v[j][2] + v[j][3] * v[j][3]); }
    s = wave_sum(s);
    unsigned long long* o8 = (unsigned long long*)orow + lane;
#pragma unroll
    for (int j = 0; j < 4; ++j) { o8[64 * j] = (unsigned long long)pk2(v[j][0], v[j][1]) | ((unsigned long long)pk2(v[j][2], v[j][3]) << 32); if (frow) ((f32x4*)frow + lane)[64 * j] = v[j]; }
    if (lane < 16) ssqrow[lane] = lane == 0 ? s : 0.f;
}


typedef short mbf16x8 __attribute__((ext_vector_type(8)));
__device__ __forceinline__ void meta_m1(int grp, const bf16* AM, const bf16* W1T, const float* SSQM0, bf16* HM, int lane) {
    const int c = lane & 15, kq = lane >> 4; f32x4 ag = {0.f, 0.f, 0.f, 0.f}, au = {0.f, 0.f, 0.f, 0.f};
    const bf16* ap = AM + (size_t)c * DM + 8 * kq; const bf16* gp = W1T + (size_t)(32 * grp + c) * DM + 8 * kq; const bf16* up = gp + (size_t)16 * DM;
#pragma unroll 8
    for (int kk = 0; kk < DM / 32; ++kk) { const mbf16x8 a = *(const mbf16x8*)(ap + kk * 32), bg = *(const mbf16x8*)(gp + kk * 32), bu = *(const mbf16x8*)(up + kk * 32);
        ag = __builtin_amdgcn_mfma_f32_16x16x32_bf16(a, bg, ag, 0, 0, 0); au = __builtin_amdgcn_mfma_f32_16x16x32_bf16(a, bu, au, 0, 0, 0); }
#pragma unroll
    for (int r = 0; r < 4; ++r) { const int m = 4 * kq + r; const float rs = epi::row_rs(SSQM0, m); const float g = ag[r] * rs, u = au[r] * rs;
        HM[(size_t)m * FF + 16 * grp + c] = (bf16)f2bf(g * epi::sigmoidf_fast(g) * u); }
}
__device__ __forceinline__ void meta_m2(int grp, const bf16* HM, const bf16* WD1T, const float* meta, float* H1M, bf16* XBM, float* SSQM1, int lane) {
    const int c = lane & 15, kq = lane >> 4; f32x4 acc = {0.f, 0.f, 0.f, 0.f};
    const bf16* ap = HM + (size_t)c * FF + 8 * kq; const bf16* bp = WD1T + (size_t)(16 * grp + c) * FF + 8 * kq;
#pragma unroll 8
    for (int kk = 0; kk < FF / 32; ++kk) { const mbf16x8 a = *(const mbf16x8*)(ap + kk * 32), b = *(const mbf16x8*)(bp + kk * 32);
        acc = __builtin_amdgcn_mfma_f32_16x16x32_bf16(a, b, acc, 0, 0, 0); }
#pragma unroll
    for (int r = 0; r < 4; ++r) { const int m = 4 * kq + r, n = 16 * grp + c; const float o = meta[(size_t)m * DM + n] + 0.5f * acc[r];
        H1M[(size_t)m * DM + n] = o; XBM[(size_t)m * DM + n] = (bf16)f2bf(o);
        float q = o * o; q += __shfl_xor(q, 1); q += __shfl_xor(q, 2); q += __shfl_xor(q, 4); q += __shfl_xor(q, 8);
        if (c == 0) SSQM1[m * 64 + grp] = q; }
}
__device__ __forceinline__ void meta_m3(int u, const bf16* XBM, const bf16* WINT, const float* SSQM1, const float* COS, const float* SIN, bf16* KA, bf16* VA, bf16* KI, bf16* KS, bf16* VS, int lane) {
    const int c = lane & 15, kq = lane >> 4; f32x4 a0 = {0.f, 0.f, 0.f, 0.f}, a1 = {0.f, 0.f, 0.f, 0.f};
    const int rowb = (u < 2) ? 512 + 32 * u : (u < 4) ? 576 + 32 * (u - 2) : (u < 6) ? 640 + 32 * (u - 4) : (u < 10) ? 1536 + 32 * (u - 6) : 1664 + 32 * (u - 10);
    const bf16* ap = XBM + (size_t)c * DM + 8 * kq; const bf16* b0 = WINT + (size_t)(rowb + c) * DM + 8 * kq; const bf16* b1 = b0 + (size_t)16 * DM;
#pragma unroll 8
    for (int kk = 0; kk < DM / 32; ++kk) { const mbf16x8 a = *(const mbf16x8*)(ap + kk * 32), x0 = *(const mbf16x8*)(b0 + kk * 32), x1 = *(const mbf16x8*)(b1 + kk * 32);
        a0 = __builtin_amdgcn_mfma_f32_16x16x32_bf16(a, x0, a0, 0, 0, 0); a1 = __builtin_amdgcn_mfma_f32_16x16x32_bf16(a, x1, a1, 0, 0, 0); }
#pragma unroll
    for (int r = 0; r < 4; ++r) { const int m = 4 * kq + r; float s = 0.f;
        for (int i = 0; i < 64; ++i) s += SSQM1[m * 64 + i];
        const float rs = __builtin_amdgcn_rsqf(s * (1.0f / 1024.0f) + EPS); const float v0 = a0[r] * rs, v1 = a1[r] * rs;
        const bool rope = (u < 2) || (u >= 4 && u < 10); const int g = (u < 2) ? u : (u < 6) ? (u - 4) : ((u - 6) & 1), i0 = 16 * g + c;
        float o0 = v0, o1 = v1; if (rope) { const float cs = COS[m * 32 + i0], sn = SIN[m * 32 + i0]; o0 = v0 * cs - v1 * sn; o1 = v1 * cs + v0 * sn; }
        for (int b = 0; b < BATCH; ++b) { const size_t kr = (size_t)b * NKV + 112 + m;
            if (u < 2) { KA[kr * 64 + i0] = (bf16)f2bf(o0); KA[kr * 64 + i0 + 32] = (bf16)f2bf(o1); }
            else if (u < 4) { VA[kr * 64 + 32 * (u - 2) + c] = (bf16)f2bf(o0); VA[kr * 64 + 32 * (u - 2) + 16 + c] = (bf16)f2bf(o1); }
            else if (u < 6) { KI[kr * 64 + i0] = __builtin_bit_cast(unsigned short, (_Float16)o0); KI[kr * 64 + i0 + 32] = __builtin_bit_cast(unsigned short, (_Float16)o1); }
            else if (u < 10) { const int hd = (u - 6) >> 1; KS[kr * 128 + hd * 64 + i0] = (bf16)f2bf(o0); KS[kr * 128 + hd * 64 + i0 + 32] = (bf16)f2bf(o1); }
            else { VS[kr * 128 + 32 * (u - 10) + c] = (bf16)f2bf(o0); VS[kr * 128 + 32 * (u - 10) + 16 + c] = (bf16)f2bf(o1); } }
    }
}

#ifndef PROBE_PHASE
#define PROBE_PHASE -1
#endif
#ifndef PROBE_REPS
#define PROBE_REPS 1
#endif
#define NREP(k) ((k) == PROBE_PHASE ? PROBE_REPS : 1)
struct Args { const float* in[17]; float* out; unsigned char* ws; int ph_lo, ph_hi, li, pad; };

__global__ void __launch_bounds__(NWAVES * 64, 2) mk_fwd(Args args) {
    extern __shared__ __attribute__((aligned(16))) unsigned char lds_raw[];
    LAS unsigned char* lds = (LAS unsigned char*)lds_raw;
    volatile LAS unsigned* MISC = (volatile LAS unsigned*)(lds + MISC_OFF);
    const int tid = threadIdx.x, lane = tid & 63; const int wave = __builtin_amdgcn_readfirstlane(tid >> 6);
    const int G = gridDim.x; int vcu; { const int bx = blockIdx.x; vcu = (G % 8 == 0) ? (bx % 8) * (G / 8) + bx / 8 : bx; }
    unsigned char* ws = args.ws;
    gu32* ctl = (gu32*)(ws + WS_CTL);
    const float* x = args.in[0];
    bf16 *W1T = (bf16*)(ws + WS_W1T), *WD1T = (bf16*)(ws + WS_WD1T), *WINT = (bf16*)(ws + WS_WINT), *WBST = (bf16*)(ws + WS_WBST), *WBWT = (bf16*)(ws + WS_WBWT),
         *WOUTT = (bf16*)(ws + WS_WOUTT), *W2T = (bf16*)(ws + WS_W2T), *WD2T = (bf16*)(ws + WS_WD2T);
    float *COS = (float*)(ws + WS_COS), *SIN = (float*)(ws + WS_SIN);
    float *SSQ0 = (float*)(ws + WS_SSQ0), *SSQ1 = (float*)(ws + WS_SSQ1), *SSQ2 = (float*)(ws + WS_SSQ2), *SSQ3 = (float*)(ws + WS_SSQ3);
    float* WI = (float*)(ws + WS_WI);
    bf16 *KA = (bf16*)(ws + WS_KA), *VA = (bf16*)(ws + WS_VA), *KI = (bf16*)(ws + WS_KI), *KS = (bf16*)(ws + WS_KS), *VS = (bf16*)(ws + WS_VS);
    bf16 *AM = (bf16*)(ws + WS_AM), *HM = (bf16*)(ws + WS_HM), *XBM = (bf16*)(ws + WS_XBM); float *SSQM0 = (float*)(ws + WS_SSQM0), *SSQM1 = (float*)(ws + WS_SSQM1), *H1M = (float*)(ws + WS_H1M);
    bf16 *XB = (bf16*)(ws + WS_XB), *HFF = (bf16*)(ws + WS_HFF), *QA = (bf16*)(ws + WS_QA), *QS = (bf16*)(ws + WS_QS), *QI = (bf16*)(ws + WS_QI), *OSP = (bf16*)(ws + WS_OSP), *OSW = (bf16*)(ws + WS_OSW),
         *MERGED = (bf16*)(ws + WS_MERGED), *SGA = (bf16*)(ws + WS_SGA), *SGB = (bf16*)(ws + WS_SGB), *T1 = XB;
    float* out = args.out;

    for (int u = tid; u < (LDS_BYTES - LDSCTL_OFF) / 4; u += NWAVES * 64) ((LAS unsigned*)(lds + LDSCTL_OFF))[u] = 0u;
    __syncthreads();
    XcdBarrier bar; bar.bar = (unsigned*)(ctl + CW_BAR); bar.x = 0; bar.st = nullptr;
    if (N_LAUNCHES != PER_PHASE) bar = xcd_barrier_post((unsigned*)(ctl + CW_BAR), MISC + 8);
#define GRID_BAR() do { if (N_LAUNCHES != PER_PHASE) xcd_barrier(bar); } while (0)
    const int lo = args.ph_lo, hi = args.ph_hi;
#define IN(k) (lo <= (k) && (k) < hi)
#define BOTH(k) (IN(k) && IN((k) + 1))
    const int gw = vcu * NWAVES + wave, NGW = G * NWAVES;

    if (IN(0)) {
        LAS float* scr = (LAS float*)(lds + RING_OFF + wave * 16384);
        constexpr int I_GU = 16 * 88, I_D = 44 * 32, I_IN = 16 * 119, I_B = 8 * 32, I_O = 16 * 32;
        constexpr int NITEMS = 4 * I_GU + 2 * I_D + I_IN + 2 * I_B + I_O;
        for (int it = gw; it < NITEMS; it += NGW) {
            int r = it;
            if (r < I_GU) { transpose_item(args.in[3], DM, FF, args.in[2], W1T, MapGateUp{0}, scr, r, lane); continue; } r -= I_GU;
            if (r < I_GU) { transpose_item(args.in[4], DM, FF, args.in[2], W1T, MapGateUp{1}, scr, r, lane); continue; } r -= I_GU;
            if (r < I_GU) { transpose_item(args.in[13], DM, FF, args.in[12], W2T, MapGateUp{0}, scr, r, lane); continue; } r -= I_GU;
            if (r < I_GU) { transpose_item(args.in[14], DM, FF, args.in[12], W2T, MapGateUp{1}, scr, r, lane); continue; } r -= I_GU;
            if (r < I_D) { transpose_item(args.in[5], FF, DM, nullptr, WD1T, MapIdent{0}, scr, r, lane); continue; } r -= I_D;
            if (r < I_D) { transpose_item(args.in[15], FF, DM, nullptr, WD2T, MapIdent{0}, scr, r, lane); continue; } r -= I_D;
            if (r < I_IN) { transpose_item(args.in[7], DM, 3780, args.in[6], WINT, MapInProj{}, scr, r, lane); continue; } r -= I_IN;
            if (r < I_B) { transpose_item(args.in[9], 512, DM, nullptr, WBST, MapIdent{0}, scr, r, lane); continue; } r -= I_B;
            if (r < I_B) { transpose_item(args.in[10], 512, DM, nullptr, WBWT, MapIdent{0}, scr, r, lane); continue; } r -= I_B;
            transpose_item(args.in[11], DM, DM, nullptr, WOUTT, MapIdent{0}, scr, r, lane);
        }
        for (int m = gw; m < MR; m += NGW) row_to_bf16_ssq(x + (size_t)m * DM, XB + (size_t)m * DM, nullptr, SSQ0 + (size_t)m * 16, lane, false);
        for (int m = gw; m < NMETA; m += NGW) row_to_bf16_ssq(args.in[1] + (size_t)m * DM, AM + (size_t)m * DM, nullptr, SSQM0 + (size_t)m * 16, lane, false);
        const int gt = vcu * (NWAVES * 64) + tid, NGT = G * NWAVES * 64;
        for (int i = gt; i < 4112 * 32; i += NGT) { const int pos = i >> 5, fi = i & 31;
            const float e = (float)(2 * fi) / 64.0f, inv = 1.0f / powf(10000.0f, e), ang = (float)pos * inv;
            COS[i] = (float)cos((double)ang); SIN[i] = (float)sin((double)ang); }
        const v4u zero4 = {0u, 0u, 0u, 0u};
        for (int i = gt; i < BATCH * 112 * 56; i += NGT) { const int c = i % 56, rs = i / 56, b = rs / 112, s = rs % 112; const size_t kr = (size_t)b * NKV + s;
            if (c < 8) *(v4u*)(KA + kr * 64 + c * 8) = zero4; else if (c < 16) *(v4u*)(VA + kr * 64 + (c - 8) * 8) = zero4; else if (c < 24) *(v4u*)(KI + kr * 64 + (c - 16) * 8) = zero4;
            else if (c < 40) *(v4u*)(KS + kr * 128 + (c - 24) * 8) = zero4; else *(v4u*)(VS + kr * 128 + (c - 40) * 8) = zero4; }
        for (int i = gt; i < 60 * 128; i += NGT) *(v4u*)(WINT + (size_t)(708 + i / 128) * DM + (i % 128) * 8) = zero4;
        if (BOTH(0)) GRID_BAR();
    }
    if (IN(1)) {
        if (wave == 0 && vcu < 176) meta_m1(vcu, AM, W1T, SSQM0, HM, lane);
        { pg8::Gemm g{XB, W1T, MR, 2 * FF, DM}; pg8::StaticOrder S; S.init(MR, 2 * FF, G, (int)blockIdx.x); epi::EpiGateUp E{HFF, SSQ0};
          pg8::gemm_phase<epi::EpiGateUp, pg8::StaticOrder, true, true>(lds + RING_OFF, g, S, E); }
        if (BOTH(1)) GRID_BAR();
    }
    if (IN(2)) {
        if (wave == 0 && vcu >= 176 && vcu < 240) meta_m2(vcu - 176, HM, WD1T, args.in[1], H1M, XBM, SSQM1, lane);
        { pg8::Gemm g{HFF, WD1T, MR, DM, FF}; pg8::StaticOrder S; S.init(MR, DM, G, (int)blockIdx.x); epi::EpiResid E{x, out, XB, SSQ1, 0.5f};
          pg8::gemm_phase<epi::EpiResid, pg8::StaticOrder, true, true>(lds + RING_OFF, g, S, E); }
        if (BOTH(2)) GRID_BAR();
    }
    if (IN(3)) {
        if (wave == 0 && vcu < 14) meta_m3(vcu, XBM, WINT, SSQM1, COS, SIN, KA, VA, KI, KS, VS, lane);
        { pg8::Gemm g{XB, WINT, MR, NIN, DM}; pg8::StaticOrder S; S.init(MR, NIN, G, (int)blockIdx.x);
          epi::EpiInProj E{SSQ1, COS, SIN, QA, KA, VA, QS, KS, VS, SGA, SGB, QI, KI, WI, 0};
          pg8::gemm_phase<epi::EpiInProj, pg8::StaticOrder, true, true>(lds + RING_OFF, g, S, E); }
        if (BOTH(3)) GRID_BAR();
    }
    if (IN(4)) {
        const float sink2 = args.in[8][wave] * LOG2E;
        for (int i = 0;; ++i) {
            int b, qt;
            if (G == 256) { if (i >= 4) break; const int j = vcu & 31; b = vcu >> 5; qt = (i == 0) ? j : (i == 1) ? 63 - j : (i == 2) ? 64 + j : 127 - j; }
            else { const int u = vcu + i * G; if (u >= BATCH * 128) break; b = u >> 7; qt = u & 127; }
            att::select_unit(lds, b, qt, QI, KI, WI, (unsigned*)(ctl + CW_ERR));
            att::attn_unit<false>(lds, b, qt, QA, KA, VA, OSP, 0.f);
            att::attn_unit<true>(lds, b, qt, QS, KS, VS, OSW, sink2);
            __syncthreads();
        }
        if (BOTH(4)) GRID_BAR();
    }
    if (IN(5)) {
        { pg8::Gemm g{OSP, WBST, MR, DM, 512}; pg8::StaticOrder S; S.init(MR, DM, G, (int)blockIdx.x); epi::EpiBranch<false> E{SGA, T1, MERGED};
          pg8::gemm_phase<epi::EpiBranch<false>, pg8::StaticOrder, true, true>(lds + RING_OFF, g, S, E); }
        { pg8::Gemm g{OSW, WBWT, MR, DM, 512}; pg8::StaticOrder S; S.init(MR, DM, G, (int)blockIdx.x); epi::EpiBranch<true> E{SGB, T1, MERGED};
          pg8::gemm_phase<epi::EpiBranch<true>, pg8::StaticOrder, true, true>(lds + RING_OFF, g, S, E); }
        if (BOTH(5)) GRID_BAR();
    }
    if (IN(6)) {
        pg8::Gemm g{MERGED, WOUTT, MR, DM, DM}; pg8::StaticOrder S; S.init(MR, DM, G, (int)blockIdx.x); epi::EpiResid E{out, out, XB, SSQ2, 1.0f};
        pg8::gemm_phase<epi::EpiResid, pg8::StaticOrder, true, true>(lds + RING_OFF, g, S, E);
        if (BOTH(6)) GRID_BAR();
    }
    if (IN(7)) {
        pg8::Gemm g{XB, W2T, MR, 2 * FF, DM}; pg8::StaticOrder S; S.init(MR, 2 * FF, G, (int)blockIdx.x); epi::EpiGateUp E{HFF, SSQ2};
        pg8::gemm_phase<epi::EpiGateUp, pg8::StaticOrder, true, true>(lds + RING_OFF, g, S, E);
        if (BOTH(7)) GRID_BAR();
    }
    if (IN(8)) {
        pg8::Gemm g{HFF, WD2T, MR, DM, FF}; pg8::StaticOrder S; S.init(MR, DM, G, (int)blockIdx.x); epi::EpiResid E{out, out, nullptr, SSQ3, 0.5f};
        pg8::gemm_phase<epi::EpiResid, pg8::StaticOrder, true, true>(lds + RING_OFF, g, S, E);
        if (BOTH(8)) GRID_BAR();
    }
    if (IN(9)) {
        const bool bad = __hip_atomic_load(ctl + CW_ERR, RLX_AGENT) != 0u || __hip_atomic_load(ctl + CW_BAR + XB_TMO, RLX_AGENT) != 0u;
        const float* gf = args.in[16];
        for (int m = gw; m < MR; m += NGW) {
            const float rs = bad ? __builtin_nanf("") : epi::row_rs(SSQ3, m);
            f32x4* o = (f32x4*)(out + (size_t)m * DM) + lane;
#pragma unroll
            for (int j = 0; j < 4; ++j) { const f32x4 gv = ((const f32x4*)gf + lane)[64 * j]; o[64 * j] = o[64 * j] * rs * gv; }
        }
    }
#undef IN
#undef BOTH
#undef GRID_BAR
}

extern "C" void kernel_launch(void* const* d_in, const int* in_sizes, int n_in, void* d_out, int out_size, void* d_ws, size_t ws_size, hipStream_t stream) {
    static int grid = 0;
    if (grid == 0) {
        if (n_in != 17 || in_sizes[0] != MR * DM || out_size != MR * DM || ws_size < WS_END) {
            fprintf(stderr, "kernel_launch: unexpected shapes (n_in %d, in0 %d, out %d, ws %zu); nothing launched\n", n_in, n_in > 0 ? in_sizes[0] : -1, out_size, ws_size); grid = -1; return; }
        int dev = 0, cus = 0, per_cu = 0;
        if (hipGetDevice(&dev) != hipSuccess || hipDeviceGetAttribute(&cus, hipDeviceAttributeMultiprocessorCount, dev) != hipSuccess) { grid = -1; return; }
        if (hipFuncSetAttribute((const void*)mk_fwd, hipFuncAttributeMaxDynamicSharedMemorySize, LDS_BYTES) != hipSuccess) { fprintf(stderr, "kernel_launch: hipFuncSetAttribute failed\n"); grid = -1; return; }
        if (hipOccupancyMaxActiveBlocksPerMultiprocessor(&per_cu, (const void*)mk_fwd, NWAVES * 64, LDS_BYTES) != hipSuccess || per_cu < 1) {
            fprintf(stderr, "kernel_launch: occupancy query reports %d workgroups per CU; nothing launched\n", per_cu); (void)hipGetLastError(); grid = -1; return; }
        grid = cus;
    }
    if (grid < 0) return;
    if (hipMemsetAsync((char*)d_ws + WS_CTL, 0, CTL_ZERO_BYTES, stream) != hipSuccess) return;
    Args a{};
    for (int i = 0; i < 17; ++i) a.in[i] = (const float*)d_in[i];
    a.out = (float*)d_out; a.ws = (unsigned char*)d_ws;
    for (int li = 0; li < N_LAUNCHES; ++li) {
        a.ph_lo = (N_LAUNCHES == PER_PHASE) ? li : 0; a.ph_hi = (N_LAUNCHES == PER_PHASE) ? li + 1 : PER_PHASE; a.li = li;
        for (int rep = 0; rep < ((N_LAUNCHES == PER_PHASE) ? NREP(li) : 1); ++rep) hipLaunchKernelGGL(mk_fwd, dim3(grid), dim3(NWAVES * 64), LDS_BYTES, stream, a);
        if (hipPeekAtLastError() != hipSuccess) { fprintf(stderr, "kernel_launch: launch %d failed\n", li); break; }
    }
}
```

```cpp
#include <hip/hip_runtime.h>
#include <cstdio>
#include <cstdint>
#include <cmath>

#ifndef MK_N_LAUNCHES
#define MK_N_LAUNCHES 1
#endif

namespace pg8 {
#define PG8_LAS __attribute__((address_space(3)))
typedef unsigned short bf16_t;
typedef short bf16x8 __attribute__((ext_vector_type(8)));
typedef float f32x4 __attribute__((ext_vector_type(4)));
typedef unsigned u32x4 __attribute__((ext_vector_type(4)));
typedef unsigned u32x2 __attribute__((ext_vector_type(2)));
constexpr int BM = 256, BK = 64, HALF = 128, HTB = HALF * BK * 2  , STAGE_BYTES = 8 * HTB, NXCD = 8, WGM = 8;

__host__ __device__ __forceinline__ int lds_byte(int r, int c) { const int st = (r >> 4) * 2 + (c >> 5), rr = r & 15, cc = c & 31, ob = rr * 64 + cc * 2; return st * 1024 + (ob ^ (((ob >> 9) & 1) << 5)); }
__host__ __device__ __forceinline__ void stage_rc(int b, int& R, int& C) { const int st = b / 1024, sb = b % 1024, swz = sb ^ (((sb >> 9) & 1) << 5); R = (st >> 1) * 16 + swz / 64; C = (st & 1) * 32 + (swz % 64) / 2; }
__host__ __device__ __forceinline__ int perm32(int rho) { const int n = rho >> 4, i = rho & 15; return 8 * (i >> 2) + 4 * n + (i & 3); }

struct Unit { int pm, pn; };
struct Gemm { const bf16_t* A; const bf16_t* Bt; int M, N, K; };

struct StaticOrder {
    int nM, nN, nwg, G, c;
    __host__ __device__ void init(int M, int N, int G_, int c_) { nM = M / BM; nN = N / BM; nwg = nM * nN; G = G_; c = c_; }
    __host__ __device__ bool next(int i, Unit& u) const {
        const long L = (long)i * G + c; if (L >= nwg) return false;
        int wgid = (int)L; { const int q = nwg / NXCD, r = nwg % NXCD, xcd = wgid % NXCD, off = wgid / NXCD; wgid = (xcd < r ? xcd * (q + 1) : r * (q + 1) + (xcd - r) * q) + off; }
        const int nig = WGM * nN, gid = wgid / nig, fm = gid * WGM, gsz = (nM - fm) < WGM ? (nM - fm) : WGM;
        u.pm = fm + ((wgid % nig) % gsz); u.pn = (wgid % nig) / gsz; return true;
    }
    __device__ __forceinline__ void a_ready(const Unit&) const {}
    __device__ __forceinline__ void done(const Unit&) const {}
};
struct ListOrder {
    int n, c, pn0, pn1;
    __device__ bool next(int i, Unit& u) const { if (i != 0 || c >= n) return false; u.pm = 0; u.pn = (pn1 >= 0) ? (c == 0 ? pn0 : pn1) : (pn0 + c); return true; }
    __device__ __forceinline__ void a_ready(const Unit&) const {}
    __device__ __forceinline__ void done(const Unit&) const {}
};

__device__ __forceinline__ unsigned cvt_pk_bf16(float lo, float hi) { unsigned r; asm volatile("v_cvt_pk_bf16_f32 %0, %1, %2" : "=v"(r) : "v"(lo), "v"(hi)); return r; }
template <class Epi, class Sched, bool ALIGN_EPI = false, bool SP2 = false>
__device__ __forceinline__ void gemm_phase(PG8_LAS unsigned char* lds, const Gemm g, const Sched& S, const Epi& E) {
    const int tid = threadIdx.x, wid = __builtin_amdgcn_readfirstlane(tid >> 6), lane = tid & 63, wr = wid >> 2, wc = wid & 3, fr = lane & 15, fq = lane >> 4;
    const int K = g.K, nt = K / BK;
    unsigned voffA[2], voffB[2];
#pragma unroll
    for (int i = 0; i < 2; ++i) { int R, C; stage_rc(tid * 16 + i * 8192, R, C); const int Rb = Epi::PERM ? ((R & ~31) + perm32(R & 31)) : R;
        voffA[i] = (unsigned)(R * K + C) * 2u; voffB[i] = (unsigned)(Rb * K + C) * 2u; }
    const size_t kstep = (size_t)(BK * 2);
    const size_t hstep = (size_t)HALF * K * 2;
    const size_t tstep = 2 * hstep;
    const unsigned ldsw = (unsigned)wid * 1024u;
    const int aoff = lds_byte(wr * 64 + fr, fq * 8), boff = lds_byte(wc * 32 + fr, fq * 8);
#define PG8_SA(b, h) (((b) * 2 + (h)) * HTB)
#define PG8_SB(b, h) ((4 + (b) * 2 + (h)) * HTB)
#define PG8_STAGE(bufoff, gbase, voff) do { _Pragma("unroll") for (int _i = 0; _i < 2; ++_i) \
        __builtin_amdgcn_global_load_lds((const unsigned*)((const char*)(gbase) + (voff)[_i]), (PG8_LAS unsigned*)(lds + (bufoff) + ldsw + _i * 8192), 16, 0, 0); } while (0)
#define PG8_LDA(dst, b, h) do { _Pragma("unroll") for (int m = 0; m < 4; ++m) _Pragma("unroll") for (int k = 0; k < 2; ++k) dst[m][k] = *(const PG8_LAS bf16x8*)(lds + PG8_SA(b, h) + aoff + m * 2048 + k * 1024); } while (0)
#define PG8_LDB(dst, b, h) do { _Pragma("unroll") for (int n = 0; n < 2; ++n) _Pragma("unroll") for (int k = 0; k < 2; ++k) dst[n][k] = *(const PG8_LAS bf16x8*)(lds + PG8_SB(b, h) + boff + n * 2048 + k * 1024); } while (0)
#define PG8_MMA(ai, bj, At, Bt) do { __builtin_amdgcn_s_setprio(1); _Pragma("unroll") for (int m = 0; m < 4; ++m) _Pragma("unroll") for (int n = 0; n < 2; ++n) _Pragma("unroll") for (int k = 0; k < 2; ++k) \
        acc[ai][bj][m][n] = __builtin_amdgcn_mfma_f32_16x16x32_bf16(Bt[n][k], At[m][k], acc[ai][bj][m][n], 0, 0, 0); __builtin_amdgcn_s_setprio(0); } while (0)
#define PG8_WAIT_V(n) asm volatile("s_waitcnt vmcnt(" #n ")" ::: "memory")
#define PG8_WAIT_L(n) asm volatile("s_waitcnt lgkmcnt(" #n ")" ::: "memory")
#define PG8_BAR __builtin_amdgcn_s_barrier()
#define PG8_SCHED __builtin_amdgcn_sched_barrier(0)
    Unit cur, nxt; int ui = 0;
    if (!S.next(0, cur)) return;
    f32x4 acc[2][2][4][2];
#pragma unroll
    for (int a = 0; a < 2; ++a)
#pragma unroll
        for (int b = 0; b < 2; ++b)
#pragma unroll
            for (int m = 0; m < 4; ++m)
#pragma unroll
                for (int n = 0; n < 2; ++n) acc[a][b][m][n] = (f32x4){0.f, 0.f, 0.f, 0.f};
    bf16x8 At[4][2], B0[2][2], B1[2][2];
    const char* cA = (const char*)g.A + (size_t)cur.pm * tstep; const char* cB = (const char*)g.Bt + (size_t)cur.pn * tstep;
    S.a_ready(cur);
    if constexpr (SP2) {
        PG8_STAGE(PG8_SB(0, 0), cB, voffB); PG8_STAGE(PG8_SB(0, 1), cB + hstep, voffB); PG8_STAGE(PG8_SA(0, 0), cA, voffA); PG8_STAGE(PG8_SA(0, 1), cA + hstep, voffA);
        if (wr == 1) PG8_BAR;
        PG8_WAIT_V(2); PG8_BAR;
        PG8_STAGE(PG8_SB(1, 0), cB + kstep, voffB); PG8_STAGE(PG8_SA(1, 0), cA + kstep, voffA); PG8_STAGE(PG8_SB(1, 1), cB + hstep + kstep, voffB);
        PG8_WAIT_V(6); PG8_BAR;
    } else {
        PG8_STAGE(PG8_SB(0, 0), cB, voffB); PG8_STAGE(PG8_SA(0, 0), cA, voffA); PG8_STAGE(PG8_SB(0, 1), cB + hstep, voffB); PG8_STAGE(PG8_SA(0, 1), cA + hstep, voffA);
        if (wr == 1) PG8_BAR;
        PG8_WAIT_V(4); PG8_BAR;
        PG8_STAGE(PG8_SB(1, 0), cB + kstep, voffB); PG8_STAGE(PG8_SA(1, 0), cA + kstep, voffA); PG8_STAGE(PG8_SB(1, 1), cB + hstep + kstep, voffB);
        PG8_WAIT_V(6); PG8_BAR;
    }
    for (;;) {
        const bool has_next = S.next(ui + 1, nxt);
        const char* nA = has_next ? (const char*)g.A + (size_t)nxt.pm * tstep : cA; const char* nB = has_next ? (const char*)g.Bt + (size_t)nxt.pn * tstep : cB;
        for (int t = 0; t < nt; t += 2) {
            const bool last = (t == nt - 2);
            const char* a1 = cA + (size_t)(t + 1) * kstep;
            const char* a2 = last ? nA : cA + (size_t)(t + 2) * kstep; const char* b2 = last ? nB : cB + (size_t)(t + 2) * kstep;
            const char* a3 = a2 + kstep; const char* b3 = b2 + kstep;
            if (last && has_next) S.a_ready(nxt);
            if constexpr (SP2) {
            PG8_LDB(B0, 0, 0); PG8_LDB(B1, 0, 1); PG8_SCHED; PG8_LDA(At, 0, 0); PG8_STAGE(PG8_SA(1, 1), a1 + hstep, voffA);
            PG8_WAIT_V(8); PG8_WAIT_L(0); PG8_BAR; PG8_MMA(0, 0, At, B0); PG8_MMA(0, 1, At, B1); PG8_BAR; PG8_SCHED;
            PG8_LDA(At, 0, 1); PG8_STAGE(PG8_SB(0, 0), b2, voffB); PG8_STAGE(PG8_SB(0, 1), b2 + hstep, voffB); PG8_STAGE(PG8_SA(0, 0), a2, voffA);
            PG8_WAIT_V(8); PG8_WAIT_L(0); PG8_BAR; PG8_MMA(1, 0, At, B0); PG8_MMA(1, 1, At, B1); PG8_BAR; PG8_SCHED;
            PG8_LDB(B0, 1, 0); PG8_LDB(B1, 1, 1); PG8_SCHED; PG8_LDA(At, 1, 0); PG8_STAGE(PG8_SA(0, 1), a2 + hstep, voffA);
            PG8_WAIT_V(8); PG8_WAIT_L(0); PG8_BAR; PG8_MMA(0, 0, At, B0); PG8_MMA(0, 1, At, B1); PG8_BAR; PG8_SCHED;
            PG8_LDA(At, 1, 1); PG8_STAGE(PG8_SB(1, 0), b3, voffB); PG8_STAGE(PG8_SB(1, 1), b3 + hstep, voffB); PG8_STAGE(PG8_SA(1, 0), a3, voffA);
            PG8_WAIT_V(8); PG8_WAIT_L(0); PG8_BAR; PG8_MMA(1, 0, At, B0); PG8_MMA(1, 1, At, B1); PG8_BAR; PG8_SCHED;
            } else {
            PG8_LDB(B0, 0, 0); PG8_SCHED; PG8_LDA(At, 0, 0); PG8_STAGE(PG8_SA(1, 1), a1 + hstep, voffA);
            PG8_WAIT_L(8); PG8_BAR; PG8_WAIT_L(0); PG8_MMA(0, 0, At, B0); PG8_BAR; PG8_SCHED;
            PG8_LDB(B1, 0, 1); PG8_STAGE(PG8_SB(0, 0), b2, voffB);
            PG8_BAR; PG8_WAIT_L(0); PG8_MMA(0, 1, At, B1); PG8_BAR;
            PG8_LDA(At, 0, 1); PG8_STAGE(PG8_SA(0, 0), a2, voffA);
            PG8_BAR; PG8_WAIT_L(0); PG8_MMA(1, 0, At, B0); PG8_BAR; PG8_SCHED;
            PG8_STAGE(PG8_SB(0, 1), b2 + hstep, voffB);
            PG8_WAIT_V(6); PG8_BAR; PG8_MMA(1, 1, At, B1); PG8_BAR;
            PG8_LDB(B0, 1, 0); PG8_SCHED; PG8_LDA(At, 1, 0); PG8_STAGE(PG8_SA(0, 1), a2 + hstep, voffA);
            PG8_WAIT_L(8); PG8_BAR; PG8_WAIT_L(0); PG8_MMA(0, 0, At, B0); PG8_BAR; PG8_SCHED;
            PG8_LDB(B1, 1, 1); PG8_STAGE(PG8_SB(1, 0), b3, voffB);
            PG8_BAR; PG8_WAIT_L(0); PG8_MMA(0, 1, At, B1); PG8_BAR;
            PG8_LDA(At, 1, 1); PG8_STAGE(PG8_SA(1, 0), a3, voffA);
            PG8_BAR; PG8_WAIT_L(0); PG8_MMA(1, 0, At, B0); PG8_BAR; PG8_SCHED;
            PG8_STAGE(PG8_SB(1, 1), b3 + hstep, voffB);
            PG8_WAIT_V(6); PG8_BAR; PG8_MMA(1, 1, At, B1); PG8_BAR;
            }
        }
        if constexpr (ALIGN_EPI) { if (wr == 0) PG8_BAR; }
        if constexpr (!Epi::AFTER_DRAIN) { E(acc, cur, wr, wc, fr, fq); S.done(cur); }
        if (!has_next) break;
#pragma unroll
        for (int a = 0; a < 2; ++a)
#pragma unroll
            for (int b = 0; b < 2; ++b)
#pragma unroll
                for (int m = 0; m < 4; ++m)
#pragma unroll
                    for (int n = 0; n < 2; ++n) acc[a][b][m][n] = (f32x4){0.f, 0.f, 0.f, 0.f};
        cur = nxt; cA = nA; cB = nB; ++ui;
        if constexpr (ALIGN_EPI) { if (wr == 1) PG8_BAR; }
    }
    PG8_WAIT_V(0);
    if constexpr (!ALIGN_EPI) { if (wr == 0) PG8_BAR; }
    PG8_BAR;
    if constexpr (Epi::AFTER_DRAIN) { E.fused(acc, cur, wr, wc, fr, fq, lds, wid, lane); S.done(cur); }
#undef PG8_SA
#undef PG8_SB
#undef PG8_STAGE
#undef PG8_LDA
#undef PG8_LDB
#undef PG8_MMA
#undef PG8_WAIT_V
#undef PG8_WAIT_L
#undef PG8_BAR
#undef PG8_SCHED
}
}

constexpr int BATCH = 8, SEQ = 4096, DM = 1024, FF = 2816, NMETA = 16;
constexpr int MR = BATCH * SEQ;
constexpr int NKV = SEQ + 128;
constexpr int NIN = 3840;
constexpr float EPS = 1e-6f;
constexpr float LOG2E = 1.4426950408889634f;
constexpr float QSCALE = 0.125f * LOG2E;
constexpr float IDX_SCALE = 0.0625f;

namespace epi {
using pg8::f32x4; using pg8::u32x2; using pg8::Unit; using pg8::bf16_t; using pg8::cvt_pk_bf16;
typedef _Float16 f16x2 __attribute__((ext_vector_type(2)));

__device__ __forceinline__ float row_rs(const float* ssq, int row) {
    const f32x4* p = (const f32x4*)(ssq + (size_t)row * 16); const f32x4 a = p[0], b = p[1], c = p[2], d = p[3];
    const float s = (((a[0] + a[1]) + (a[2] + a[3])) + ((b[0] + b[1]) + (b[2] + b[3]))) + (((c[0] + c[1]) + (c[2] + c[3])) + ((d[0] + d[1]) + (d[2] + d[3])));
    return __builtin_amdgcn_rsqf(s * (1.0f / 1024.0f) + EPS);
}
__device__ __forceinline__ float sigmoidf_fast(float x) { return __builtin_amdgcn_rcpf(1.0f + __builtin_amdgcn_exp2f(-x * LOG2E)); }
__device__ __forceinline__ u32x2 pack4(const f32x4 v) { u32x2 w; w.x = cvt_pk_bf16(v[0], v[1]); w.y = cvt_pk_bf16(v[2], v[3]); return w; }
__device__ __forceinline__ unsigned pk_f16(float lo, float hi) { f16x2 h; h.x = (_Float16)lo; h.y = (_Float16)hi; return __builtin_bit_cast(unsigned, h); }
__device__ __forceinline__ u32x2 pack4h(const f32x4 v) { u32x2 w; w.x = pk_f16(v[0], v[1]); w.y = pk_f16(v[2], v[3]); return w; }
__device__ __forceinline__ f32x4 unpack4(const u32x2 w) { f32x4 v; v[0] = __uint_as_float(w.x << 16); v[1] = __uint_as_float(w.x & 0xffff0000u); v[2] = __uint_as_float(w.y << 16); v[3] = __uint_as_float(w.y & 0xffff0000u); return v; }


struct EpiGateUp {
    static constexpr bool PERM = false, AFTER_DRAIN = false;
    bf16_t* H; const float* ssq;
    __device__ __forceinline__ void operator()(const f32x4 (&acc)[2][2][4][2], const Unit& u, int wr, int wc, int fr, int fq) const {
#pragma unroll
        for (int ai = 0; ai < 2; ++ai)
#pragma unroll
            for (int m = 0; m < 4; ++m) {
                const int row = u.pm * 256 + ai * 128 + wr * 64 + m * 16 + fr; const float rs = row_rs(ssq, row);
                bf16_t* hp = H + (size_t)row * FF + u.pn * 128 + wc * 16 + fq * 4;
#pragma unroll
                for (int bj = 0; bj < 2; ++bj) { const f32x4 g = acc[ai][bj][m][0] * rs, up = acc[ai][bj][m][1] * rs; f32x4 h;
#pragma unroll
                    for (int e = 0; e < 4; ++e) h[e] = g[e] * sigmoidf_fast(g[e]) * up[e];
                    *(u32x2*)(hp + bj * 64) = pack4(h); }
            }
    }
};

struct EpiResid {
    static constexpr bool PERM = false, AFTER_DRAIN = false;
    const float* res; float* out; bf16_t* xb; float* ssq; float alpha;
    __device__ __forceinline__ void operator()(const f32x4 (&acc)[2][2][4][2], const Unit& u, int wr, int wc, int fr, int fq) const {
#pragma unroll
        for (int ai = 0; ai < 2; ++ai)
#pragma unroll
            for (int m = 0; m < 4; ++m) {
                const int row = u.pm * 256 + ai * 128 + wr * 64 + m * 16 + fr; const size_t off = (size_t)row * DM + u.pn * 256 + wc * 32 + fq * 4; float q = 0.f;
#pragma unroll
                for (int bj = 0; bj < 2; ++bj)
#pragma unroll
                    for (int n = 0; n < 2; ++n) { const size_t o2 = off + bj * 128 + n * 16; const f32x4 r = *(const f32x4*)(res + o2); const f32x4 o = r + acc[ai][bj][m][n] * alpha;
                        *(f32x4*)(out + o2) = o; q += (o[0] * o[0] + o[1] * o[1]) + (o[2] * o[2] + o[3] * o[3]);
                        if (xb) *(u32x2*)(xb + o2) = pack4(o); }
                q += __shfl_xor(q, 16); q += __shfl_xor(q, 32);
                if (fq == 0) ssq[(size_t)row * 16 + u.pn * 4 + wc] = q;
            }
    }
};

template <bool SECOND> struct EpiBranch {
    static constexpr bool PERM = false, AFTER_DRAIN = false;
    const bf16_t* sg; bf16_t* t1; bf16_t* outp;
    __device__ __forceinline__ void operator()(const f32x4 (&acc)[2][2][4][2], const Unit& u, int wr, int wc, int fr, int fq) const {
#pragma unroll
        for (int ai = 0; ai < 2; ++ai)
#pragma unroll
            for (int m = 0; m < 4; ++m) {
                const int row = u.pm * 256 + ai * 128 + wr * 64 + m * 16 + fr; const size_t off = (size_t)row * DM + u.pn * 256 + wc * 32 + fq * 4;
#pragma unroll
                for (int bj = 0; bj < 2; ++bj)
#pragma unroll
                    for (int n = 0; n < 2; ++n) { const size_t o2 = off + bj * 128 + n * 16; const f32x4 g = unpack4(*(const u32x2*)(sg + o2)); f32x4 o = g * acc[ai][bj][m][n];
                        if (SECOND) o = o + unpack4(*(const u32x2*)(t1 + o2));
                        *(u32x2*)((SECOND ? outp : t1) + o2) = pack4(o); }
            }
    }
};

struct EpiInProj {
    static constexpr bool PERM = false, AFTER_DRAIN = false;
    const float* ssq; const float* cosT; const float* sinT;
    bf16_t *QA, *KA, *VA, *QS, *KS, *VS, *SGA, *SGB; unsigned short *QI, *KI; float* WI; int meta;
    template <int MODE  > static __device__ __forceinline__ void rope_store(unsigned short* d, const f32x4 x1, const f32x4 x2, const f32x4 c, const f32x4 s, float sc) {
        const f32x4 o1 = (x1 * c - x2 * s) * sc, o2 = (x2 * c + x1 * s) * sc;
        if (MODE == 0) { *(u32x2*)d = pack4(o1); *(u32x2*)(d + 32) = pack4(o2); } else { *(u32x2*)d = pack4h(o1); *(u32x2*)(d + 32) = pack4h(o2); }
    }
    __device__ __forceinline__ void operator()(const f32x4 (&acc)[2][2][4][2], const Unit& u, int wr, int wc, int fr, int fq) const {
        const int pn = u.pn, g = wc & 1, hq = wc >> 1;
#pragma unroll
        for (int ai = 0; ai < 2; ++ai)
#pragma unroll
            for (int m = 0; m < 4; ++m) {
                const int rloc = ai * 128 + wr * 64 + m * 16 + fr, row = u.pm * 256 + rloc;
                if (meta && (ai | wr | m)) continue;
                const float rs = row_rs(ssq, row);
                int pos, krow; if (!meta) { const int b = row >> 12, t = row & 4095; pos = 16 + t; krow = b * NKV + 128 + t; } else { pos = rloc; krow = 112 + rloc; }
                const int nrep = meta ? BATCH : 1;
                if (pn < 7) {
                    const f32x4 c4 = *(const f32x4*)(cosT + pos * 32 + 16 * g + 4 * fq), s4 = *(const f32x4*)(sinT + pos * 32 + 16 * g + 4 * fq);
                    const int i0 = 16 * g + 4 * fq;
#pragma unroll
                    for (int bj = 0; bj < 2; ++bj) {
                        const f32x4 v0 = acc[ai][bj][m][0] * rs, v1 = acc[ai][bj][m][1] * rs;
                        if (pn <= 1) { if (!meta) rope_store<0>(QA + (size_t)row * 512 + (pn * 4 + bj * 2 + hq) * 64 + i0, v0, v1, c4, s4, QSCALE); }
                        else if (pn == 3) { if (!meta) rope_store<1>(QI + (size_t)row * 256 + (bj * 2 + hq) * 64 + i0, v0, v1, c4, s4, 1.0f); }
                        else if (pn <= 5 && pn >= 4) { if (!meta) rope_store<0>(QS + (size_t)row * 512 + ((pn - 4) * 4 + bj * 2 + hq) * 64 + i0, v0, v1, c4, s4, QSCALE); }
                        else if (pn == 2) {
                            for (int rep = 0; rep < nrep; ++rep) { const size_t kr = (size_t)krow + (size_t)rep * NKV;
                                if (bj == 0) { if (wc < 2) rope_store<0>(KA + kr * 64 + i0, v0, v1, c4, s4, 1.0f);
                                               else { bf16_t* d = VA + kr * 64 + 32 * (wc - 2) + 4 * fq; *(u32x2*)d = pack4(v0); *(u32x2*)(d + 16) = pack4(v1); } }
                                else if (wc < 2) rope_store<1>(KI + kr * 64 + i0, v0, v1, c4, s4, 1.0f); }
                            if (bj == 1 && wc == 2 && fq == 0 && !meta) *(f32x4*)(WI + (size_t)row * 4) = v0 * IDX_SCALE;
                        } else {
                            for (int rep = 0; rep < nrep; ++rep) { const size_t kr = (size_t)krow + (size_t)rep * NKV;
                                if (bj == 0) rope_store<0>(KS + kr * 128 + hq * 64 + i0, v0, v1, c4, s4, 1.0f);
                                else { bf16_t* d = VS + kr * 128 + 32 * wc + 4 * fq; *(u32x2*)d = pack4(v0); *(u32x2*)(d + 16) = pack4(v1); } }
                        }
                    }
                } else if (!meta) {
                    bf16_t* d = (pn < 11 ? SGA + (size_t)(pn - 7) * 256 : SGB + (size_t)(pn - 11) * 256) + (size_t)row * DM + wc * 32 + fq * 4;
#pragma unroll
                    for (int bj = 0; bj < 2; ++bj)
#pragma unroll
                        for (int n = 0; n < 2; ++n) { const f32x4 v = acc[ai][bj][m][n] * rs; f32x4 o;
#pragma unroll
                            for (int e = 0; e < 4; ++e) o[e] = sigmoidf_fast(v[e]);
                            *(u32x2*)(d + bj * 128 + n * 16) = pack4(o); }
                }
            }
    }
};
}

namespace att {
#define ALAS __attribute__((address_space(3)))
typedef _Float16 f16x8 __attribute__((ext_vector_type(8)));
typedef short bf16x8 __attribute__((ext_vector_type(8)));
typedef short s16x4 __attribute__((ext_vector_type(4)));
typedef float f32x16 __attribute__((ext_vector_type(16)));
typedef float f32x4 __attribute__((ext_vector_type(4)));
typedef unsigned u32x4 __attribute__((ext_vector_type(4)));
typedef unsigned u32x2 __attribute__((ext_vector_type(2)));
typedef unsigned short u16;

constexpr int HSTRIDE = 769, HMID = 384;
constexpr int CAND_CAP = 500, CSTRIDE = 501;
constexpr int L_MASK = 131072, MASK_W = 136;
constexpr int L_QINFO = L_MASK + 32 * MASK_W * 4;
constexpr int L_WSF = L_QINFO + 512;
constexpr int L_TRASH = L_WSF + 8 * 64 * 4;
constexpr int L_END = L_TRASH + 8 * 64 * 8;
constexpr int L_KBUF = 0, L_VBUF = 32768, L_OST = 65536;
static_assert(32 * HSTRIDE * 4 <= L_MASK && 32 * CSTRIDE * 8 <= L_MASK, "selection LDS map");

__device__ __forceinline__ int crow(int r, int hi) { return (r & 3) + 8 * (r >> 2) + 4 * hi; }
__device__ __forceinline__ unsigned swap_or(unsigned w) { auto rr = __builtin_amdgcn_permlane32_swap(w, w, false, false); return rr[0] | rr[1]; }
__device__ __forceinline__ float max2_s(float a, float b) { float r; asm("v_max_f32_e32 %0, %1, %2" : "=v"(r) : "v"(a), "v"(b)); return r; }
__device__ __forceinline__ float max3_s(float a, float b, float c) { float r; asm("v_max3_f32 %0, %1, %2, %3" : "=v"(r) : "v"(a), "v"(b), "v"(c)); return r; }
__device__ __forceinline__ unsigned bfe1_s(unsigned w, int pos) { unsigned r; asm("v_bfe_i32 %0, %1, %2, 1" : "=v"(r) : "v"(w), "n"(pos)); return r; }
__device__ __forceinline__ float relu_s(float a) { float r; asm("v_max_f32_e32 %0, 0, %1" : "=v"(r) : "v"(a)); return r; }
__device__ __forceinline__ float swap_max(float m) { auto rr = __builtin_amdgcn_permlane32_swap(__float_as_uint(m), __float_as_uint(m), false, false); return max2_s(__uint_as_float(rr[0]), __uint_as_float(rr[1])); }
__device__ __forceinline__ float swap_add(float m) { auto rr = __builtin_amdgcn_permlane32_swap(__float_as_uint(m), __float_as_uint(m), false, false); return __uint_as_float(rr[0]) + __uint_as_float(rr[1]); }

__device__ __forceinline__ float idx_score(const f32x4 w, float d0, float d1, float d2, float d3) {
    float sc = fmaf(w[0], relu_s(d0), 0.0f); sc = fmaf(w[1], relu_s(d1), sc); sc = fmaf(w[2], relu_s(d2), sc); return fmaf(w[3], relu_s(d3), sc);
}
__device__ __forceinline__ int idx_bin(unsigned bits) {
    int t = (int)__builtin_amdgcn_ubfe(bits, 19, 12) - 1775; t = t < 0 ? 0 : (t > 353 ? 353 : t);
    return t ^ ((int)bits >> 31);
}

template <int PASS, bool EDGE> __device__ __forceinline__ void select_block(ALAS unsigned char* lds, const f32x16& a0, const f32x16& a1, const f32x16& a2, const f32x16& a3, const f32x4 w4,
                                                                          int kb, int sq, int r32, int hi, int binstar, int wid, int lane) {
    ALAS unsigned* hist = (ALAS unsigned*)lds;
    if (PASS == 0) {
        const unsigned hb = (unsigned)(size_t)(hist + r32 * HSTRIDE + HMID);
#pragma unroll
        for (int r = 0; r < 16; ++r) {
            const float sc = idx_score(w4, a0[r], a1[r], a2[r], a3[r]); const int bin = idx_bin(__float_as_uint(sc));
            unsigned inc = 1u; if (EDGE) { const int s = kb * 32 + crow(r, hi); inc = ((s >= 112) && (s <= sq)) ? 1u : 0u; }
            __hip_atomic_fetch_add((ALAS unsigned*)(size_t)(hb + (unsigned)(bin << 2)), inc, __ATOMIC_RELAXED, __HIP_MEMORY_SCOPE_WORKGROUP);
        }
    } else {
        ALAS unsigned* qinfo = (ALAS unsigned*)(lds + L_QINFO);
        const unsigned cb = (unsigned)(size_t)(lds + r32 * (CSTRIDE * 8)), tb = (unsigned)(size_t)(lds + L_TRASH + wid * 512 + lane * 8);
        unsigned wsel = 0u;
#pragma unroll
        for (int g8 = 1; g8 >= 0; --g8) {
            unsigned slot[8]; unsigned weq = 0u;
#pragma unroll
            for (int rr = 7; rr >= 0; --rr) { const int r = g8 * 8 + rr;
                const float sc = idx_score(w4, a0[r], a1[r], a2[r], a3[r]); const int bin = idx_bin(__float_as_uint(sc));
                bool sel = bin > binstar, eq = bin == binstar;
                if (EDGE) { const int s = kb * 32 + crow(r, hi); const bool valid = (s >= 112) && (s <= sq); sel = sel && valid; eq = eq && valid; }
                wsel = wsel + wsel + (sel ? 1u : 0u); weq = weq + weq + (eq ? 1u : 0u);
                slot[rr] = __hip_atomic_fetch_add(qinfo + r32 * 4 + 2, eq ? 1u : 0u, __ATOMIC_RELAXED, __HIP_MEMORY_SCOPE_WORKGROUP);
            }
#pragma unroll
            for (int rr = 0; rr < 8; ++rr) { const int r = g8 * 8 + rr;
                const float sc = idx_score(w4, a0[r], a1[r], a2[r], a3[r]); const unsigned bits = __float_as_uint(sc);
                const bool eq = (weq >> rr) & 1u; const unsigned sl = slot[rr] < (unsigned)CAND_CAP ? slot[rr] : (unsigned)CAND_CAP;
                const unsigned addr = eq ? cb + sl * 8u : tb;
                u32x2 e; e.x = ~(unsigned)(kb * 32 + crow(r, hi)); e.y = bits ^ ((unsigned)((int)bits >> 31) | 0x80000000u);
                *(ALAS u32x2*)(size_t)addr = e;
            }
        }
        unsigned word = (wsel & 0xfu) | ((wsel & 0xf0u) << 4) | ((wsel & 0xf00u) << 8) | ((wsel & 0xf000u) << 12);
        word = swap_or(word << (4 * hi));
        if (hi == 0) ((ALAS unsigned*)(lds + L_MASK))[r32 * MASK_W + kb] = word;
    }
}

template <int PASS> __device__ __forceinline__ void select_pass(ALAS unsigned char* lds, int b, int qt, const f16x8 (&qf)[4][4], const f32x4 w4, const u16* KI, int sq, int r32, int hi, int wid, int lane) {
    int binstar = 0; if (PASS) binstar = (int)((ALAS unsigned*)(lds + L_QINFO))[r32 * 4 + 0];
    const int kb_last = 4 + qt;
    const u16* kbase = KI + ((size_t)b * NKV + r32) * 64 + hi * 8;
    int kb = 3 + wid;
    f16x8 kf[4];
    if (kb <= kb_last) {
#pragma unroll
        for (int ks = 0; ks < 4; ++ks) kf[ks] = *(const f16x8*)(kbase + (size_t)kb * 32 * 64 + ks * 16); }
    for (; kb <= kb_last; kb += 8) {
        f32x16 a0 = {}, a1 = {}, a2 = {}, a3 = {};
#pragma unroll
        for (int ks = 0; ks < 4; ++ks) {
            a0 = __builtin_amdgcn_mfma_f32_32x32x16_f16(kf[ks], qf[0][ks], a0, 0, 0, 0);
            a1 = __builtin_amdgcn_mfma_f32_32x32x16_f16(kf[ks], qf[1][ks], a1, 0, 0, 0);
            a2 = __builtin_amdgcn_mfma_f32_32x32x16_f16(kf[ks], qf[2][ks], a2, 0, 0, 0);
            a3 = __builtin_amdgcn_mfma_f32_32x32x16_f16(kf[ks], qf[3][ks], a3, 0, 0, 0);
        }
        if (kb + 8 <= kb_last) {
#pragma unroll
            for (int ks = 0; ks < 4; ++ks) kf[ks] = *(const f16x8*)(kbase + (size_t)(kb + 8) * 32 * 64 + ks * 16); }
        if (kb == 3 || kb == kb_last) select_block<PASS, true>(lds, a0, a1, a2, a3, w4, kb, sq, r32, hi, binstar, wid, lane);
        else select_block<PASS, false>(lds, a0, a1, a2, a3, w4, kb, sq, r32, hi, binstar, wid, lane);
    }
}

__device__ __forceinline__ void select_unit(ALAS unsigned char* lds, int b, int qt, const u16* QI, const u16* KI, const float* WI, unsigned* err, int steps) {
    int tid = threadIdx.x; asm volatile("" : "+v"(tid));
    const int lane = tid & 63, r32 = lane & 31, hi = lane >> 5; const int wid = __builtin_amdgcn_readfirstlane(tid >> 6);
    ALAS unsigned* hist = (ALAS unsigned*)lds;
    ALAS unsigned* maskw = (ALAS unsigned*)(lds + L_MASK);
    ALAS unsigned* qinfo = (ALAS unsigned*)(lds + L_QINFO);
    { const u32x4 zero = {0u, 0u, 0u, 0u};
      ALAS u32x4* z = (ALAS u32x4*)lds; for (int i = tid; i < (32 * HSTRIDE * 4 + 15) / 16; i += 512) z[i] = zero;
      ALAS u32x4* z2 = (ALAS u32x4*)(lds + L_MASK); for (int i = tid; i < (L_WSF - L_MASK) / 16; i += 512) z2[i] = zero; }
    const size_t row0 = (size_t)b * SEQ + 32 * qt;
    f16x8 qf[4][4];
#pragma unroll
    for (int h = 0; h < 4; ++h)
#pragma unroll
        for (int ks = 0; ks < 4; ++ks) qf[h][ks] = *(const f16x8*)(QI + (row0 + r32) * 256 + h * 64 + ks * 16 + hi * 8);
    const f32x4 w4 = *(const f32x4*)(WI + (row0 + r32) * 4);
    const int sq = 128 + 32 * qt + r32;
    __syncthreads();
    if (steps & 2) select_pass<0>(lds, b, qt, qf, w4, KI, sq, r32, hi, wid, lane);
    __syncthreads();
    if (steps & 4) for (int qq = 0; qq < 4; ++qq) {
        const int q = wid * 4 + qq; int kq = 32 * qt + q + 17; kq = kq > 256 ? 256 : kq;
        const ALAS unsigned* hp = hist + q * HSTRIDE + lane * 12;
        unsigned sum = 0u;
#pragma unroll
        for (int i = 0; i < 12; ++i) sum += hp[i];
        unsigned I = sum;
#pragma unroll
        for (int o = 1; o < 64; o <<= 1) { const unsigned y = __shfl_down(I, o); if (lane + o < 64) I += y; }
        const unsigned above = I - sum; const bool hit = (I >= (unsigned)kq) && (above < (unsigned)kq);
        const unsigned long long bal = __ballot(hit);
        const int lstar = bal ? (__ffsll((long long)bal) - 1) : 0;
        const unsigned aboveS = __shfl(above, lstar);
        unsigned c = 0u; if (lane < 12) c = hist[q * HSTRIDE + lstar * 12 + lane];
        unsigned I2 = c;
#pragma unroll
        for (int o = 1; o < 16; o <<= 1) { const unsigned y = __shfl_down(I2, o); if (lane + o < 64) I2 += y; }
        const bool hit2 = (lane < 12) && (aboveS + I2 >= (unsigned)kq) && (aboveS + I2 - c < (unsigned)kq);
        if (hit2) { qinfo[q * 4 + 0] = (unsigned)(lstar * 12 + lane - HMID); qinfo[q * 4 + 1] = aboveS + I2 - c; qinfo[q * 4 + 3] = (unsigned)kq; }
    }
    __syncthreads();
    if (steps & 8) select_pass<1>(lds, b, qt, qf, w4, KI, sq, r32, hi, wid, lane);
    __syncthreads();
    if (steps & 16) for (int qq = 0; qq < 4; ++qq) {
        const int q = wid * 4 + qq; const unsigned nraw = qinfo[q * 4 + 2]; int n = nraw > (unsigned)CAND_CAP ? CAND_CAP : (int)nraw; if ((steps & 32) && n > 64) n = 64;
        const int rneed = (int)qinfo[q * 4 + 3] - (int)qinfo[q * 4 + 1];
        if (nraw > (unsigned)CAND_CAP && lane == 0) atomicOr(err, 2u);
        const ALAS unsigned long long* cl = (const ALAS unsigned long long*)(lds + q * (CSTRIDE * 8));
        const int bs = (int)qinfo[q * 4 + 0], bidx = bs < 0 ? ~bs : bs;
        const bool regular = (bidx > 0) && (bidx < 353);
        if (n <= 64) {
            const unsigned long long me = (lane < n) ? cl[lane] : 0ull;
            unsigned long long pre = 0x00000000FFFFE000ull; int bit = 63;
            if (regular) { const unsigned long long k0 = cl[0]; pre |= (k0 & 0xFFF8000000000000ull); bit = 50; }
            if (rneed < n) for (;;) { const unsigned long long t = pre | (1ull << bit); const int cnt = __popcll(__ballot(me >= t));
                if (cnt >= rneed) pre = t; if (cnt == rneed) break;
                if (bit == 32) bit = 12; else if (bit == 0) break; else --bit; }
            if (me >= pre && lane < n) { const unsigned s = ~(unsigned)me; __hip_atomic_fetch_or(maskw + q * MASK_W + (s >> 5), 1u << (s & 31u), __ATOMIC_RELAXED, __HIP_MEMORY_SCOPE_WORKGROUP); }
        } else {
            unsigned long long me[8];
#pragma unroll
            for (int c = 0; c < 8; ++c) me[c] = (c * 64 + lane < n) ? cl[c * 64 + lane] : 0ull;
            const int nch = (n + 63) >> 6;
            unsigned long long pre = 0x00000000FFFFE000ull; int bit = 63;
            if (regular) { const unsigned long long k0 = cl[0]; pre |= (k0 & 0xFFF8000000000000ull); bit = 50; }
            if (rneed < n) for (;;) { const unsigned long long t = pre | (1ull << bit); int cnt = 0;
#pragma unroll
                for (int c = 0; c < 8; ++c) if (c < nch) cnt += __popcll(__ballot(me[c] >= t));
                if (cnt >= rneed) pre = t; if (cnt == rneed) break;
                if (bit == 32) bit = 12; else if (bit == 0) break; else --bit; }
#pragma unroll
            for (int c = 0; c < 8; ++c) if (c < nch && me[c] >= pre) { const unsigned s = ~(unsigned)me[c]; __hip_atomic_fetch_or(maskw + q * MASK_W + (s >> 5), 1u << (s & 31u), __ATOMIC_RELAXED, __HIP_MEMORY_SCOPE_WORKGROUP); }
        }
    }
    __syncthreads();
}

__device__ __forceinline__ void pv(f32x16* o, int vb, bf16x8 pa0, bf16x8 pa1, bf16x8 pa2, bf16x8 pa3) {
#pragma unroll
    for (int d0 = 0; d0 < 2; ++d0) { s16x4 lo[4], hi[4];
#pragma unroll
        for (int ks = 0; ks < 4; ++ks) {
            asm volatile("ds_read_b64_tr_b16 %0,%1 offset:%c2" : "=&v"(lo[ks]) : "v"(vb), "i"(d0 * 4096 + ks * 1024) : "memory");
            asm volatile("ds_read_b64_tr_b16 %0,%1 offset:%c2" : "=&v"(hi[ks]) : "v"(vb), "i"(d0 * 4096 + ks * 1024 + 512) : "memory"); }
        asm volatile("s_waitcnt lgkmcnt(0)" ::: "memory"); __builtin_amdgcn_sched_barrier(0);
#define ATT_PK(k) (bf16x8){lo[k][0], lo[k][1], lo[k][2], lo[k][3], hi[k][0], hi[k][1], hi[k][2], hi[k][3]}
        o[d0] = __builtin_amdgcn_mfma_f32_32x32x16_bf16(pa0, ATT_PK(0), o[d0], 0, 0, 0);
        o[d0] = __builtin_amdgcn_mfma_f32_32x32x16_bf16(pa1, ATT_PK(1), o[d0], 0, 0, 0);
        o[d0] = __builtin_amdgcn_mfma_f32_32x32x16_bf16(pa2, ATT_PK(2), o[d0], 0, 0, 0);
        o[d0] = __builtin_amdgcn_mfma_f32_32x32x16_bf16(pa3, ATT_PK(3), o[d0], 0, 0, 0);
#undef ATT_PK
    }
}

template <bool SWA> __device__ __forceinline__ void attn_unit(ALAS unsigned char* lds, int b, int qt, const u16* Q, const u16* K, const u16* V, u16* O, float sink2) {
    constexpr int KP = SWA ? 128 : 64, NH = SWA ? 2 : 1;
    int tid = threadIdx.x; asm volatile("" : "+v"(tid));
    const int lane = tid & 63, r32 = lane & 31, hi = lane >> 5; const int wid = __builtin_amdgcn_readfirstlane(tid >> 6);
    const int kvh = SWA ? (wid >> 2) : 0;
    const size_t row0 = (size_t)b * SEQ + 32 * qt;
    bf16x8 qr[4];
#pragma unroll
    for (int d0 = 0; d0 < 4; ++d0) qr[d0] = *(const bf16x8*)(Q + (row0 + r32) * 512 + wid * 64 + d0 * 16 + hi * 8);
    const int sq = 128 + 32 * qt + r32;
    const int j_lo = SWA ? (qt >> 1) : 1, j_hi = (qt >> 1) + 2;
    const u16* Kb = K + (size_t)b * NKV * KP; const u16* Vb = V + (size_t)b * NKV * KP;
    const int skey = tid & 63, schunk = tid >> 6;
    const int vrow = 16 * ((tid >> 6) & 3) + (lane >> 2), vdh = tid >> 8, vpc = lane & 3;
    ALAS const unsigned* maskw = (ALAS const unsigned*)(lds + L_MASK) + r32 * MASK_W;
    ALAS float* wsf = (ALAS float*)(lds + L_WSF) + wid * 64;
    u32x4 kreg[NH], vreg[NH];
#define ATT_LOAD(j) do { _Pragma("unroll") for (int hd = 0; hd < NH; ++hd) { \
        kreg[hd] = *(const u32x4*)(Kb + (size_t)(64 * (j) + skey) * KP + hd * 64 + schunk * 8); \
        vreg[hd] = *(const u32x4*)(Vb + (size_t)(64 * (j) + vrow) * KP + hd * 64 + vdh * 32 + vpc * 8); } } while (0)
#define ATT_STORE(buf) do { _Pragma("unroll") for (int hd = 0; hd < NH; ++hd) { \
        *(ALAS u32x4*)(lds + L_KBUF + (buf) * 16384 + hd * 8192 + tid * 16) = kreg[hd]; \
        *(ALAS u32x4*)(lds + L_VBUF + (buf) * 16384 + hd * 8192 + tid * 16) = vreg[hd]; } } while (0)
    float m_run = SWA ? sink2 : 0.0f, lsum = (SWA && hi == 0) ? 1.0f : 0.0f;
    f32x16 negm;
#pragma unroll
    for (int r = 0; r < 16; ++r) negm[r] = -m_run;
    f32x16 o[2]; o[0] = f32x16{}; o[1] = f32x16{};
    ATT_LOAD(j_lo); ATT_STORE(0);
    __syncthreads();
    int cur = 0;
    for (int j = j_lo; j <= j_hi; ++j) {
        const bool more = j < j_hi;
        if (more) ATT_LOAD(j + 1);
        f32x16 p0, p1;
        { ALAS const unsigned char* kb = lds + L_KBUF + cur * 16384 + kvh * 8192 + hi * 1024 + r32 * 16;
#pragma unroll
          for (int d0 = 0; d0 < 4; ++d0) { const bf16x8 b0 = *(ALAS const bf16x8*)(kb + d0 * 2048), b1 = *(ALAS const bf16x8*)(kb + d0 * 2048 + 512);
              if (d0 == 0) { p0 = __builtin_amdgcn_mfma_f32_32x32x16_bf16(b0, qr[0], negm, 0, 0, 0); p1 = __builtin_amdgcn_mfma_f32_32x32x16_bf16(b1, qr[0], negm, 0, 0, 0); }
              else { p0 = __builtin_amdgcn_mfma_f32_32x32x16_bf16(b0, qr[d0], p0, 0, 0, 0); p1 = __builtin_amdgcn_mfma_f32_32x32x16_bf16(b1, qr[d0], p1, 0, 0, 0); } } }
        unsigned w0, w1;
        if (SWA) {
            const int los = (sq - 127) > 112 ? (sq - 127) : 112;
            { const int base = 64 * j; const int a = los - base, e = sq - base; const int a2 = a < 0 ? 0 : a, e2 = e > 31 ? 31 : e;
              w0 = (a2 > 31 || e2 < 0 || a2 > e2) ? 0u : ((0xffffffffu >> (31 - e2)) & (0xffffffffu << a2)); }
            { const int base = 64 * j + 32; const int a = los - base, e = sq - base; const int a2 = a < 0 ? 0 : a, e2 = e > 31 ? 31 : e;
              w1 = (a2 > 31 || e2 < 0 || a2 > e2) ? 0u : ((0xffffffffu >> (31 - e2)) & (0xffffffffu << a2)); }
        } else { const u32x2 ww = *(ALAS const u32x2*)(maskw + 2 * j); w0 = ww.x; w1 = ww.y; }
        w0 >>= 4 * hi; w1 >>= 4 * hi;
        float tm;
        { float a = max3_s(p0[0], p0[1], p1[0]), c = max3_s(p0[2], p0[3], p1[1]); a = max3_s(a, p1[2], p1[3]);
#pragma unroll
          for (int r = 4; r < 16; r += 4) { a = max3_s(a, p0[r], p0[r + 1]); c = max3_s(c, p0[r + 2], p0[r + 3]); a = max3_s(a, p1[r], p1[r + 1]); c = max3_s(c, p1[r + 2], p1[r + 3]); }
          tm = swap_max(max2_s(a, c)); }
        const bool first = (j == j_lo);
        if (first || __any(tm > 8.0f)) {
            const float dl = (first && !SWA) ? tm : max2_s(tm, 0.0f);
            m_run += dl;
#pragma unroll
            for (int r = 0; r < 16; ++r) { p0[r] -= dl; p1[r] -= dl; negm[r] = -m_run; }
            const float alpha = __builtin_amdgcn_exp2f(-dl);
            lsum *= alpha;
            if (!first) {
                if (hi == 0) wsf[r32] = alpha;
                asm volatile("s_waitcnt lgkmcnt(0)" ::: "memory");
#pragma unroll
                for (int r = 0; r < 16; ++r) { const float f = wsf[crow(r, hi)]; o[0][r] *= f; o[1][r] *= f; }
            }
        }
        float sacc = 0.f;
#pragma unroll
        for (int r = 0; r < 16; ++r) {
            const float e0 = __uint_as_float(__float_as_uint(__builtin_amdgcn_exp2f(p0[r])) & bfe1_s(w0, (r & 3) + 8 * (r >> 2)));
            const float e1 = __uint_as_float(__float_as_uint(__builtin_amdgcn_exp2f(p1[r])) & bfe1_s(w1, (r & 3) + 8 * (r >> 2)));
            p0[r] = e0; p1[r] = e1; sacc += e0; sacc += e1; }
        lsum += sacc;
        u32x4 pw0, pw1, pw2, pw3;
#define ATT_PKW(P, B) pg8::cvt_pk_bf16(P[B], P[B + 1])
        pw0 = (u32x4){ATT_PKW(p0, 0), ATT_PKW(p0, 2), ATT_PKW(p0, 4), ATT_PKW(p0, 6)}; pw1 = (u32x4){ATT_PKW(p0, 8), ATT_PKW(p0, 10), ATT_PKW(p0, 12), ATT_PKW(p0, 14)};
        pw2 = (u32x4){ATT_PKW(p1, 0), ATT_PKW(p1, 2), ATT_PKW(p1, 4), ATT_PKW(p1, 6)}; pw3 = (u32x4){ATT_PKW(p1, 8), ATT_PKW(p1, 10), ATT_PKW(p1, 12), ATT_PKW(p1, 14)};
#undef ATT_PKW
        const int vb = (int)(size_t)(lds + L_VBUF + cur * 16384 + kvh * 8192) + ((lane >> 4) & 1) * 32 + (lane & 3) * 8 + (4 * hi + ((lane & 15) >> 2)) * 64;
        pv(o, vb, __builtin_bit_cast(bf16x8, pw0), __builtin_bit_cast(bf16x8, pw1), __builtin_bit_cast(bf16x8, pw2), __builtin_bit_cast(bf16x8, pw3));
        if (more) ATT_STORE(cur ^ 1);
        __syncthreads();
        cur ^= 1;
    }
#undef ATT_LOAD
#undef ATT_STORE
    lsum = swap_add(lsum);
    if (hi == 0) wsf[32 + r32] = lsum;
    asm volatile("s_waitcnt lgkmcnt(0)" ::: "memory");
    ALAS u16* stg = (ALAS u16*)(lds + L_OST + wid * 4096);
#pragma unroll
    for (int r = 0; r < 16; ++r) { const int orow = crow(r, hi); const float rl = __builtin_amdgcn_rcpf(wsf[32 + orow]);
#pragma unroll
        for (int d0 = 0; d0 < 2; ++d0) stg[orow * 64 + d0 * 32 + r32] = (u16)(pg8::cvt_pk_bf16(o[d0][r] * rl, 0.f) & 0xffffu); }
    asm volatile("s_waitcnt lgkmcnt(0)" ::: "memory");
#pragma unroll
    for (int i = 0; i < 4; ++i) { const int row = i * 8 + (lane >> 3), ch = lane & 7; const u32x4 v = *(ALAS const u32x4*)(stg + row * 64 + ch * 8);
        *(u32x4*)(O + (row0 + row) * 512 + wid * 64 + ch * 8) = v; }
    asm volatile("s_waitcnt lgkmcnt(0)" ::: "memory");
}
}

constexpr int NWAVES = 8;
constexpr int N_LAUNCHES = MK_N_LAUNCHES;
constexpr int PER_PHASE = 10;

constexpr size_t MiB = 1u << 20;
constexpr size_t WS_CTL = 0, CTL_ZERO_BYTES = 1 * MiB;
constexpr size_t WS_W1T = 1 * MiB, WS_WD1T = 12 * MiB, WS_WINT = 18 * MiB, WS_WBST = 26 * MiB, WS_WBWT = 27 * MiB, WS_WOUTT = 28 * MiB, WS_W2T = 30 * MiB, WS_WD2T = 41 * MiB;
constexpr size_t WS_COS = 47 * MiB, WS_SIN = 48 * MiB;
constexpr size_t WS_SSQ0 = 49 * MiB, WS_SSQ1 = 51 * MiB, WS_SSQ2 = 53 * MiB, WS_SSQ3 = 55 * MiB;
constexpr size_t WS_WI = 57 * MiB, WS_KA = 58 * MiB, WS_VA = 63 * MiB, WS_KI = 68 * MiB, WS_KS = 73 * MiB, WS_VS = 82 * MiB;
constexpr size_t WS_AM = 91 * MiB, WS_SSQM0 = 91 * MiB + 512 * 1024, WS_SSQM1 = 91 * MiB + 768 * 1024, WS_HM = 92 * MiB, WS_XBM = 93 * MiB + 512 * 1024, WS_H0M = 94 * MiB, WS_H1M = 95 * MiB;
constexpr size_t WS_XB = 96 * MiB;
constexpr size_t WS_HFF = 160 * MiB;
constexpr size_t WS_QA = 160 * MiB, WS_QS = 192 * MiB, WS_QI = 224 * MiB, WS_OSP = 240 * MiB, WS_OSW = 272 * MiB, WS_MERGED = 160 * MiB;
constexpr size_t WS_SGA = 336 * MiB, WS_SGB = 400 * MiB, WS_END = 464 * MiB;
constexpr int CW_ERR = 0;
constexpr int CW_BAR = 4096;

constexpr int RING_OFF = 0, RING_BYTES = 131072;
constexpr int LDSCTL_OFF = 155136, MISC_OFF = LDSCTL_OFF + 320;
constexpr int LDS_BYTES = 155648;
static_assert(att::L_END <= LDSCTL_OFF && MISC_OFF + 128 <= LDS_BYTES, "LDS map");

#define GAS __attribute__((address_space(1)))
#define LAS __attribute__((address_space(3)))
typedef unsigned short bf16;
typedef unsigned v4u __attribute__((ext_vector_type(4)));
typedef float f32x4 __attribute__((ext_vector_type(4)));
typedef GAS unsigned gu32;
#define RLX_AGENT __ATOMIC_RELAXED, __HIP_MEMORY_SCOPE_AGENT
#define LDS_WAIT() asm volatile("s_waitcnt lgkmcnt(0)" ::: "memory")
__device__ __forceinline__ unsigned f2bf(float f) { unsigned u = __builtin_bit_cast(unsigned, f); return (u + 0x7fffu + ((u >> 16) & 1u)) >> 16; }
__device__ __forceinline__ unsigned pk2(float lo, float hi) { return f2bf(lo) | (f2bf(hi) << 16); }
#define XB_TMO      128
#define XB_XCNT(j)  (256  + 64 * (j))
#define XB_XSUB(j)  (1280 + 64 * (j))
#define XB_XGEN(j)  (2304 + 64 * (j))
#define XB_TOP      3328
#define XB_TOPGEN   3392
#define XCD_BAR_WORDS 3456
#define XB_SPIN_CAP (1u << 22)

__device__ __forceinline__ unsigned xb_ld(unsigned* p)              { return __hip_atomic_load(p, __ATOMIC_RELAXED, __HIP_MEMORY_SCOPE_AGENT); }
__device__ __forceinline__ unsigned xb_add(unsigned* p, unsigned v) { return __hip_atomic_fetch_add(p, v, __ATOMIC_RELAXED, __HIP_MEMORY_SCOPE_AGENT); }
__device__ __forceinline__ unsigned xb_xcc_id() { return (unsigned)__builtin_amdgcn_s_getreg((3 << 11) | 20) & 0xFu; }
#define XB_SPIN(cond, bar) do { unsigned _sp = 0; while (cond) { __builtin_amdgcn_s_sleep(1); \
    if ((++_sp & 255u) == 0u) { if (xb_ld(&(bar)[XB_TMO])) break; if (_sp > XB_SPIN_CAP) { atomicAdd(&(bar)[XB_TMO], 1u); break; } } } } while (0)

struct XcdBarrier {
    unsigned* bar; unsigned x;
    volatile LAS unsigned* st;
};

__device__ __forceinline__ XcdBarrier xcd_barrier_post(unsigned* bar, volatile LAS unsigned* st) {
    XcdBarrier b; b.bar = bar; b.x = xb_xcc_id(); b.st = st;
    if (threadIdx.x == 0) (void)xb_add(&bar[XB_XCNT(b.x)], 1u);
    return b;
}
__device__ __forceinline__ void xcd_barrier_complete(unsigned* bar, unsigned x, unsigned& nloc, unsigned& nx) {
    const unsigned G = gridDim.x * gridDim.y * gridDim.z;
    unsigned sum, cnt, mine, sp = 0u;
    for (;;) {
        sum = 0u; cnt = 0u; mine = 0u;
#pragma unroll
        for (unsigned j = 0; j < 16; ++j) { const unsigned c = xb_ld(&bar[XB_XCNT(j)]); sum += c; cnt += (c > 0u) ? 1u : 0u; mine = (j == x) ? c : mine; }
        if (sum == G) break;
        __builtin_amdgcn_s_sleep(1);
        if ((++sp & 255u) == 0u) { if (xb_ld(&bar[XB_TMO])) break; if (sp > XB_SPIN_CAP) { atomicAdd(&bar[XB_TMO], 1u); break; } }
    }
    nloc = mine > 0u ? mine : 1u; nx = cnt > 0u ? cnt : 1u;
}

__device__ __forceinline__ void xcd_barrier(const XcdBarrier& b) {
    asm volatile("s_waitcnt vmcnt(0)" ::: "memory");
    __syncthreads();
    if (threadIdx.x == 0) {
        unsigned* bar = b.bar;
        __builtin_amdgcn_s_waitcnt(0);
        unsigned nloc = b.st[0], nx = b.st[1];
        if (nloc == 0u) { xcd_barrier_complete(bar, b.x, nloc, nx); b.st[0] = nloc; b.st[1] = nx; }
        const unsigned old = xb_add(&bar[XB_XSUB(b.x)], 1u);
        const unsigned gen = old / nloc;
        if (old + 1u == (gen + 1u) * nloc) {
            __builtin_amdgcn_fence(__ATOMIC_RELEASE, "agent");
            asm volatile("s_waitcnt vmcnt(0)" ::: "memory");
            const unsigned og = xb_add(&bar[XB_TOP], 1u);
            const unsigned tg = og / nx;
            if (og + 1u == (tg + 1u) * nx) xb_add(&bar[XB_TOPGEN], 1u);
            else XB_SPIN(xb_ld(&bar[XB_TOPGEN]) == tg, bar);
            __builtin_amdgcn_fence(__ATOMIC_ACQUIRE, "agent");
            xb_add(&bar[XB_XGEN(b.x)], 1u);
            asm volatile("s_waitcnt vmcnt(0)" ::: "memory");
        } else {
            XB_SPIN(xb_ld(&bar[XB_XGEN(b.x)]) == gen, bar);
            __builtin_amdgcn_fence(__ATOMIC_ACQUIRE, "agent");
            asm volatile("s_waitcnt vmcnt(0)" ::: "memory");
        }
    }
    __syncthreads();
}

__device__ __forceinline__ float wave_sum(float v) {
#pragma unroll
    for (int o = 1; o < 64; o <<= 1) v += __shfl_xor(v, o);
    return v;
}
__device__ __forceinline__ int ropepos(int w) { const int i = w & 31, half = w >> 5; return 32 * (i >> 4) + 16 * half + (i & 15); }
struct MapIdent { int off; __device__ __forceinline__ int operator()(int n) const { return off + n; } };
struct MapGateUp { int type; __device__ __forceinline__ int operator()(int j) const { return (j >> 4) * 32 + type * 16 + (j & 15); } };
struct MapInProj { __device__ __forceinline__ int operator()(int n) const {
    if (n < 512) return (n >> 6) * 64 + ropepos(n & 63);
    if (n < 576) return 512 + ropepos(n - 512);
    if (n < 640) return 576 + (n - 576);
    if (n < 896) { const int m = n - 640; return 768 + (m >> 6) * 64 + ropepos(m & 63); }
    if (n < 960) return 640 + ropepos(n - 896);
    if (n < 964) return 704 + (n - 960);
    if (n < 1476) { const int m = n - 964; return 1024 + (m >> 6) * 64 + ropepos(m & 63); }
    if (n < 1604) { const int m = n - 1476; return 1536 + (m >> 6) * 64 + ropepos(m & 63); }
    if (n < 1732) return 1664 + (n - 1604);
    if (n < 2756) return 1792 + (n - 1732);
    return 2816 + (n - 2756);
} };
template <class Map> __device__ __forceinline__ void transpose_item(const float* W, int K, int N, const float* gain, bf16* WT, const Map& map, LAS float* scr, int item, int lane) {
    const int nblk = (N + 31) / 32, kb = item / nblk, nb = item % nblk, k0 = 64 * kb, n0 = 32 * nb, n = n0 + (lane & 31);
#pragma unroll 8
    for (int i = 0; i < 32; ++i) { const int kk = 2 * i + (lane >> 5); float v = 0.f; if (n < N) { v = W[(size_t)(k0 + kk) * N + n]; if (gain) v *= gain[k0 + kk]; } scr[kk * 33 + (lane & 31)] = v; }
    LDS_WAIT(); asm volatile("" ::: "memory");
    const int c = lane & 7;
#pragma unroll
    for (int j = 0; j < 4; ++j) { const int nl = (lane >> 3) + 8 * j; if (n0 + nl < N) { const LAS float* s = scr + (8 * c) * 33 + nl;
        v4u o; o.x = pk2(s[0 * 33], s[1 * 33]); o.y = pk2(s[2 * 33], s[3 * 33]); o.z = pk2(s[4 * 33], s[5 * 33]); o.w = pk2(s[6 * 33], s[7 * 33]);
        *(v4u*)(WT + (size_t)map(n0 + nl) * K + k0 + 8 * c) = o; } }
    LDS_WAIT(); asm volatile("" ::: "memory");
}
__device__ __forceinline__ void row_to_bf16_ssq(const float* xrow, bf16* orow, float* frow, float* ssqrow, int lane, bool zero) {
    const f32x4* xr = (const f32x4*)xrow + lane; f32x4 v[4]; float s = 0.f;
#pragma unroll
    for (int j = 0; j < 4; ++j) { v[j] = zero ? (f32x4){0.f, 0.f, 0.f, 0.f} : xr[64 * j]; s += (v[j][0] * v[j][0] + v[j][1] * v[j][1]) + (v[j][2] * v[j][2] + v[j][3] * v[j][3]); }
    s = wave_sum(s);
    unsigned long long* o8 = (unsigned long long*)orow + lane;
#pragma unroll
    for (int j = 0; j < 4; ++j) { o8[64 * j] = (unsigned long long)pk2(v[j][0], v[j][1]) | ((unsigned long long)pk2(v[j][2], v[j][3]) << 32); if (frow) ((f32x4*)frow + lane)[64 * j] = v[j]; }
    if (lane < 16) ssqrow[lane] = lane == 0 ? s : 0.f;
}


typedef short mbf16x8 __attribute__((ext_vector_type(8)));
__device__ __forceinline__ void meta_m1(int grp, const bf16* AM, const bf16* W1T, const float* SSQM0, bf16* HM, int lane) {
    const int c = lane & 15, kq = lane >> 4; f32x4 ag = {0.f, 0.f, 0.f, 0.f}, au = {0.f, 0.f, 0.f, 0.f};
    const bf16* ap = AM + (size_t)c * DM + 8 * kq; const bf16* gp = W1T + (size_t)(32 * grp + c) * DM + 8 * kq; const bf16* up = gp + (size_t)16 * DM;
#pragma unroll 8
    for (int kk = 0; kk < DM / 32; ++kk) { const mbf16x8 a = *(const mbf16x8*)(ap + kk * 32), bg = *(const mbf16x8*)(gp + kk * 32), bu = *(const mbf16x8*)(up + kk * 32);
        ag = __builtin_amdgcn_mfma_f32_16x16x32_bf16(a, bg, ag, 0, 0, 0); au = __builtin_amdgcn_mfma_f32_16x16x32_bf16(a, bu, au, 0, 0, 0); }
#pragma unroll
    for (int r = 0; r < 4; ++r) { const int m = 4 * kq + r; const float rs = epi::row_rs(SSQM0, m); const float g = ag[r] * rs, u = au[r] * rs;
        HM[(size_t)m * FF + 16 * grp + c] = (bf16)f2bf(g * epi::sigmoidf_fast(g) * u); }
}
__device__ __forceinline__ void meta_m2(int grp, const bf16* HM, const bf16* WD1T, const float* meta, float* H1M, bf16* XBM, float* SSQM1, int lane) {
    const int c = lane & 15, kq = lane >> 4; f32x4 acc = {0.f, 0.f, 0.f, 0.f};
    const bf16* ap = HM + (size_t)c * FF + 8 * kq; const bf16* bp = WD1T + (size_t)(16 * grp + c) * FF + 8 * kq;
#pragma unroll 8
    for (int kk = 0; kk < FF / 32; ++kk) { const mbf16x8 a = *(const mbf16x8*)(ap + kk * 32), b = *(const mbf16x8*)(bp + kk * 32);
        acc = __builtin_amdgcn_mfma_f32_16x16x32_bf16(a, b, acc, 0, 0, 0); }
#pragma unroll
    for (int r = 0; r < 4; ++r) { const int m = 4 * kq + r, n = 16 * grp + c; const float o = meta[(size_t)m * DM + n] + 0.5f * acc[r];
        H1M[(size_t)m * DM + n] = o; XBM[(size_t)m * DM + n] = (bf16)f2bf(o);
        float q = o * o; q += __shfl_xor(q, 1); q += __shfl_xor(q, 2); q += __shfl_xor(q, 4); q += __shfl_xor(q, 8);
        if (c == 0) SSQM1[m * 64 + grp] = q; }
}
__device__ __forceinline__ void meta_m3(int u, const bf16* XBM, const bf16* WINT, const float* SSQM1, const float* COS, const float* SIN, bf16* KA, bf16* VA, bf16* KI, bf16* KS, bf16* VS, int lane) {
    const int c = lane & 15, kq = lane >> 4; f32x4 a0 = {0.f, 0.f, 0.f, 0.f}, a1 = {0.f, 0.f, 0.f, 0.f};
    const int rowb = (u < 2) ? 512 + 32 * u : (u < 4) ? 576 + 32 * (u - 2) : (u < 6) ? 640 + 32 * (u - 4) : (u < 10) ? 1536 + 32 * (u - 6) : 1664 + 32 * (u - 10);
    const bf16* ap = XBM + (size_t)c * DM + 8 * kq; const bf16* b0 = WINT + (size_t)(rowb + c) * DM + 8 * kq; const bf16* b1 = b0 + (size_t)16 * DM;
#pragma unroll 8
    for (int kk = 0; kk < DM / 32; ++kk) { const mbf16x8 a = *(const mbf16x8*)(ap + kk * 32), x0 = *(const mbf16x8*)(b0 + kk * 32), x1 = *(const mbf16x8*)(b1 + kk * 32);
        a0 = __builtin_amdgcn_mfma_f32_16x16x32_bf16(a, x0, a0, 0, 0, 0); a1 = __builtin_amdgcn_mfma_f32_16x16x32_bf16(a, x1, a1, 0, 0, 0); }
#pragma unroll
    for (int r = 0; r < 4; ++r) { const int m = 4 * kq + r; float s = 0.f;
        for (int i = 0; i < 64; ++i) s += SSQM1[m * 64 + i];
        const float rs = __builtin_amdgcn_rsqf(s * (1.0f / 1024.0f) + EPS); const float v0 = a0[r] * rs, v1 = a1[r] * rs;
        const bool rope = (u < 2) || (u >= 4 && u < 10); const int g = (u < 2) ? u : (u < 6) ? (u - 4) : ((u - 6) & 1), i0 = 16 * g + c;
        float o0 = v0, o1 = v1; if (rope) { const float cs = COS[m * 32 + i0], sn = SIN[m * 32 + i0]; o0 = v0 * cs - v1 * sn; o1 = v1 * cs + v0 * sn; }
        for (int b = 0; b < BATCH; ++b) { const size_t kr = (size_t)b * NKV + 112 + m;
            if (u < 2) { KA[kr * 64 + i0] = (bf16)f2bf(o0); KA[kr * 64 + i0 + 32] = (bf16)f2bf(o1); }
            else if (u < 4) { VA[kr * 64 + 32 * (u - 2) + c] = (bf16)f2bf(o0); VA[kr * 64 + 32 * (u - 2) + 16 + c] = (bf16)f2bf(o1); }
            else if (u < 6) { KI[kr * 64 + i0] = __builtin_bit_cast(unsigned short, (_Float16)o0); KI[kr * 64 + i0 + 32] = __builtin_bit_cast(unsigned short, (_Float16)o1); }
            else if (u < 10) { const int hd = (u - 6) >> 1; KS[kr * 128 + hd * 64 + i0] = (bf16)f2bf(o0); KS[kr * 128 + hd * 64 + i0 + 32] = (bf16)f2bf(o1); }
            else { VS[kr * 128 + 32 * (u - 10) + c] = (bf16)f2bf(o0); VS[kr * 128 + 32 * (u - 10) + 16 + c] = (bf16)f2bf(o1); } }
    }
}

#ifndef PROBE_PHASE
#define PROBE_PHASE -1
#endif
#ifndef PROBE_REPS
#define PROBE_REPS 1
#endif
#define NREP(k) ((k) == PROBE_PHASE ? PROBE_REPS : 1)
#ifndef PROBE_MODE
#define PROBE_MODE 7
#endif
struct Args { const float* in[17]; float* out; unsigned char* ws; int ph_lo, ph_hi, li, mode; };

__global__ void __launch_bounds__(NWAVES * 64, 2) mk_fwd(Args args) {
    extern __shared__ __attribute__((aligned(16))) unsigned char lds_raw[];
    LAS unsigned char* lds = (LAS unsigned char*)lds_raw;
    volatile LAS unsigned* MISC = (volatile LAS unsigned*)(lds + MISC_OFF);
    const int tid = threadIdx.x, lane = tid & 63; const int wave = __builtin_amdgcn_readfirstlane(tid >> 6);
    const int G = gridDim.x; int vcu; { const int bx = blockIdx.x; vcu = (G % 8 == 0) ? (bx % 8) * (G / 8) + bx / 8 : bx; }
    unsigned char* ws = args.ws;
    gu32* ctl = (gu32*)(ws + WS_CTL);
    const float* x = args.in[0];
    bf16 *W1T = (bf16*)(ws + WS_W1T), *WD1T = (bf16*)(ws + WS_WD1T), *WINT = (bf16*)(ws + WS_WINT), *WBST = (bf16*)(ws + WS_WBST), *WBWT = (bf16*)(ws + WS_WBWT),
         *WOUTT = (bf16*)(ws + WS_WOUTT), *W2T = (bf16*)(ws + WS_W2T), *WD2T = (bf16*)(ws + WS_WD2T);
    float *COS = (float*)(ws + WS_COS), *SIN = (float*)(ws + WS_SIN);
    float *SSQ0 = (float*)(ws + WS_SSQ0), *SSQ1 = (float*)(ws + WS_SSQ1), *SSQ2 = (float*)(ws + WS_SSQ2), *SSQ3 = (float*)(ws + WS_SSQ3);
    float* WI = (float*)(ws + WS_WI);
    bf16 *KA = (bf16*)(ws + WS_KA), *VA = (bf16*)(ws + WS_VA), *KI = (bf16*)(ws + WS_KI), *KS = (bf16*)(ws + WS_KS), *VS = (bf16*)(ws + WS_VS);
    bf16 *AM = (bf16*)(ws + WS_AM), *HM = (bf16*)(ws + WS_HM), *XBM = (bf16*)(ws + WS_XBM); float *SSQM0 = (float*)(ws + WS_SSQM0), *SSQM1 = (float*)(ws + WS_SSQM1), *H1M = (float*)(ws + WS_H1M);
    bf16 *XB = (bf16*)(ws + WS_XB), *HFF = (bf16*)(ws + WS_HFF), *QA = (bf16*)(ws + WS_QA), *QS = (bf16*)(ws + WS_QS), *QI = (bf16*)(ws + WS_QI), *OSP = (bf16*)(ws + WS_OSP), *OSW = (bf16*)(ws + WS_OSW),
         *MERGED = (bf16*)(ws + WS_MERGED), *SGA = (bf16*)(ws + WS_SGA), *SGB = (bf16*)(ws + WS_SGB), *T1 = XB;
    float* out = args.out;

    for (int u = tid; u < (LDS_BYTES - LDSCTL_OFF) / 4; u += NWAVES * 64) ((LAS unsigned*)(lds + LDSCTL_OFF))[u] = 0u;
    __syncthreads();
    XcdBarrier bar; bar.bar = (unsigned*)(ctl + CW_BAR); bar.x = 0; bar.st = nullptr;
    if (N_LAUNCHES != PER_PHASE) bar = xcd_barrier_post((unsigned*)(ctl + CW_BAR), MISC + 8);
#define GRID_BAR() do { if (N_LAUNCHES != PER_PHASE) xcd_barrier(bar); } while (0)
    const int lo = args.ph_lo, hi = args.ph_hi;
#define IN(k) (lo <= (k) && (k) < hi)
#define BOTH(k) (IN(k) && IN((k) + 1))
    const int gw = vcu * NWAVES + wave, NGW = G * NWAVES;

    if (IN(0)) {
        LAS float* scr = (LAS float*)(lds + RING_OFF + wave * 16384);
        constexpr int I_GU = 16 * 88, I_D = 44 * 32, I_IN = 16 * 119, I_B = 8 * 32, I_O = 16 * 32;
        constexpr int NITEMS = 4 * I_GU + 2 * I_D + I_IN + 2 * I_B + I_O;
        for (int it = gw; it < NITEMS; it += NGW) {
            int r = it;
            if (r < I_GU) { transpose_item(args.in[3], DM, FF, args.in[2], W1T, MapGateUp{0}, scr, r, lane); continue; } r -= I_GU;
            if (r < I_GU) { transpose_item(args.in[4], DM, FF, args.in[2], W1T, MapGateUp{1}, scr, r, lane); continue; } r -= I_GU;
            if (r < I_GU) { transpose_item(args.in[13], DM, FF, args.in[12], W2T, MapGateUp{0}, scr, r, lane); continue; } r -= I_GU;
            if (r < I_GU) { transpose_item(args.in[14], DM, FF, args.in[12], W2T, MapGateUp{1}, scr, r, lane); continue; } r -= I_GU;
            if (r < I_D) { transpose_item(args.in[5], FF, DM, nullptr, WD1T, MapIdent{0}, scr, r, lane); continue; } r -= I_D;
            if (r < I_D) { transpose_item(args.in[15], FF, DM, nullptr, WD2T, MapIdent{0}, scr, r, lane); continue; } r -= I_D;
            if (r < I_IN) { transpose_item(args.in[7], DM, 3780, args.in[6], WINT, MapInProj{}, scr, r, lane); continue; } r -= I_IN;
            if (r < I_B) { transpose_item(args.in[9], 512, DM, nullptr, WBST, MapIdent{0}, scr, r, lane); continue; } r -= I_B;
            if (r < I_B) { transpose_item(args.in[10], 512, DM, nullptr, WBWT, MapIdent{0}, scr, r, lane); continue; } r -= I_B;
            transpose_item(args.in[11], DM, DM, nullptr, WOUTT, MapIdent{0}, scr, r, lane);
        }
        for (int m = gw; m < MR; m += NGW) row_to_bf16_ssq(x + (size_t)m * DM, XB + (size_t)m * DM, nullptr, SSQ0 + (size_t)m * 16, lane, false);
        for (int m = gw; m < NMETA; m += NGW) row_to_bf16_ssq(args.in[1] + (size_t)m * DM, AM + (size_t)m * DM, nullptr, SSQM0 + (size_t)m * 16, lane, false);
        const int gt = vcu * (NWAVES * 64) + tid, NGT = G * NWAVES * 64;
        for (int i = gt; i < 4112 * 32; i += NGT) { const int pos = i >> 5, fi = i & 31;
            const float e = (float)(2 * fi) / 64.0f, inv = 1.0f / powf(10000.0f, e), ang = (float)pos * inv;
            COS[i] = (float)cos((double)ang); SIN[i] = (float)sin((double)ang); }
        const v4u zero4 = {0u, 0u, 0u, 0u};
        for (int i = gt; i < BATCH * 112 * 56; i += NGT) { const int c = i % 56, rs = i / 56, b = rs / 112, s = rs % 112; const size_t kr = (size_t)b * NKV + s;
            if (c < 8) *(v4u*)(KA + kr * 64 + c * 8) = zero4; else if (c < 16) *(v4u*)(VA + kr * 64 + (c - 8) * 8) = zero4; else if (c < 24) *(v4u*)(KI + kr * 64 + (c - 16) * 8) = zero4;
            else if (c < 40) *(v4u*)(KS + kr * 128 + (c - 24) * 8) = zero4; else *(v4u*)(VS + kr * 128 + (c - 40) * 8) = zero4; }
        for (int i = gt; i < 60 * 128; i += NGT) *(v4u*)(WINT + (size_t)(708 + i / 128) * DM + (i % 128) * 8) = zero4;
        if (BOTH(0)) GRID_BAR();
    }
    if (IN(1)) {
        if (wave == 0 && vcu < 176) meta_m1(vcu, AM, W1T, SSQM0, HM, lane);
        { pg8::Gemm g{XB, W1T, MR, 2 * FF, DM}; pg8::StaticOrder S; S.init(MR, 2 * FF, G, (int)blockIdx.x); epi::EpiGateUp E{HFF, SSQ0};
          pg8::gemm_phase<epi::EpiGateUp, pg8::StaticOrder, true, true>(lds + RING_OFF, g, S, E); }
        if (BOTH(1)) GRID_BAR();
    }
    if (IN(2)) {
        if (wave == 0 && vcu >= 176 && vcu < 240) meta_m2(vcu - 176, HM, WD1T, args.in[1], H1M, XBM, SSQM1, lane);
        { pg8::Gemm g{HFF, WD1T, MR, DM, FF}; pg8::StaticOrder S; S.init(MR, DM, G, (int)blockIdx.x); epi::EpiResid E{x, out, XB, SSQ1, 0.5f};
          pg8::gemm_phase<epi::EpiResid, pg8::StaticOrder, true, true>(lds + RING_OFF, g, S, E); }
        if (BOTH(2)) GRID_BAR();
    }
    if (IN(3)) {
        if (wave == 0 && vcu < 14) meta_m3(vcu, XBM, WINT, SSQM1, COS, SIN, KA, VA, KI, KS, VS, lane);
        { pg8::Gemm g{XB, WINT, MR, NIN, DM}; pg8::StaticOrder S; S.init(MR, NIN, G, (int)blockIdx.x);
          epi::EpiInProj E{SSQ1, COS, SIN, QA, KA, VA, QS, KS, VS, SGA, SGB, QI, KI, WI, 0};
          pg8::gemm_phase<epi::EpiInProj, pg8::StaticOrder, true, true>(lds + RING_OFF, g, S, E); }
        if (BOTH(3)) GRID_BAR();
    }
    if (IN(4)) {
        const float sink2 = args.in[8][wave] * LOG2E;
        for (int i = 0;; ++i) {
            int b, qt;
            if (G == 256) { if (i >= 4) break; const int j = vcu & 31; b = vcu >> 5; qt = (i == 0) ? j : (i == 1) ? 63 - j : (i == 2) ? 64 + j : 127 - j; }
            else { const int u = vcu + i * G; if (u >= BATCH * 128) break; b = u >> 7; qt = u & 127; }
            if (args.mode & 1) att::select_unit(lds, b, qt, QI, KI, WI, (unsigned*)(ctl + CW_ERR), args.mode >> 8);
            if (args.mode & 2) att::attn_unit<false>(lds, b, qt, QA, KA, VA, OSP, 0.f);
            if (args.mode & 4) att::attn_unit<true>(lds, b, qt, QS, KS, VS, OSW, sink2);
            __syncthreads();
        }
        if (BOTH(4)) GRID_BAR();
    }
    if (IN(5)) {
        { pg8::Gemm g{OSP, WBST, MR, DM, 512}; pg8::StaticOrder S; S.init(MR, DM, G, (int)blockIdx.x); epi::EpiBranch<false> E{SGA, T1, MERGED};
          pg8::gemm_phase<epi::EpiBranch<false>, pg8::StaticOrder, true, true>(lds + RING_OFF, g, S, E); }
        { pg8::Gemm g{OSW, WBWT, MR, DM, 512}; pg8::StaticOrder S; S.init(MR, DM, G, (int)blockIdx.x); epi::EpiBranch<true> E{SGB, T1, MERGED};
          pg8::gemm_phase<epi::EpiBranch<true>, pg8::StaticOrder, true, true>(lds + RING_OFF, g, S, E); }
        if (BOTH(5)) GRID_BAR();
    }
    if (IN(6)) {
        pg8::Gemm g{MERGED, WOUTT, MR, DM, DM}; pg8::StaticOrder S; S.init(MR, DM, G, (int)blockIdx.x); epi::EpiResid E{out, out, XB, SSQ2, 1.0f};
        pg8::gemm_phase<epi::EpiResid, pg8::StaticOrder, true, true>(lds + RING_OFF, g, S, E);
        if (BOTH(6)) GRID_BAR();
    }
    if (IN(7)) {
        pg8::Gemm g{XB, W2T, MR, 2 * FF, DM}; pg8::StaticOrder S; S.init(MR, 2 * FF, G, (int)blockIdx.x); epi::EpiGateUp E{HFF, SSQ2};
        pg8::gemm_phase<epi::EpiGateUp, pg8::StaticOrder, true, true>(lds + RING_OFF, g, S, E);
        if (BOTH(7)) GRID_BAR();
    }
    if (IN(8)) {
        pg8::Gemm g{HFF, WD2T, MR, DM, FF}; pg8::StaticOrder S; S.init(MR, DM, G, (int)blockIdx.x); epi::EpiResid E{out, out, nullptr, SSQ3, 0.5f};
        pg8::gemm_phase<epi::EpiResid, pg8::StaticOrder, true, true>(lds + RING_OFF, g, S, E);
        if (BOTH(8)) GRID_BAR();
    }
    if (IN(9)) {
        const bool bad = __hip_atomic_load(ctl + CW_ERR, RLX_AGENT) != 0u || __hip_atomic_load(ctl + CW_BAR + XB_TMO, RLX_AGENT) != 0u;
        const float* gf = args.in[16];
        for (int m = gw; m < MR; m += NGW) {
            const float rs = bad ? __builtin_nanf("") : epi::row_rs(SSQ3, m);
            f32x4* o = (f32x4*)(out + (size_t)m * DM) + lane;
#pragma unroll
            for (int j = 0; j < 4; ++j) { const f32x4 gv = ((const f32x4*)gf + lane)[64 * j]; o[64 * j] = o[64 * j] * rs * gv; }
        }
    }
#undef IN
#undef BOTH
#undef GRID_BAR
}

extern "C" void kernel_launch(void* const* d_in, const int* in_sizes, int n_in, void* d_out, int out_size, void* d_ws, size_t ws_size, hipStream_t stream) {
    static int grid = 0;
    if (grid == 0) {
        if (n_in != 17 || in_sizes[0] != MR * DM || out_size != MR * DM || ws_size < WS_END) {
            fprintf(stderr, "kernel_launch: unexpected shapes (n_in %d, in0 %d, out %d, ws %zu); nothing launched\n", n_in, n_in > 0 ? in_sizes[0] : -1, out_size, ws_size); grid = -1; return; }
        int dev = 0, cus = 0, per_cu = 0;
        if (hipGetDevice(&dev) != hipSuccess || hipDeviceGetAttribute(&cus, hipDeviceAttributeMultiprocessorCount, dev) != hipSuccess) { grid = -1; return; }
        if (hipFuncSetAttribute((const void*)mk_fwd, hipFuncAttributeMaxDynamicSharedMemorySize, LDS_BYTES) != hipSuccess) { fprintf(stderr, "kernel_launch: hipFuncSetAttribute failed\n"); grid = -1; return; }
        if (hipOccupancyMaxActiveBlocksPerMultiprocessor(&per_cu, (const void*)mk_fwd, NWAVES * 64, LDS_BYTES) != hipSuccess || per_cu < 1) {
            fprintf(stderr, "kernel_launch: occupancy query reports %d workgroups per CU; nothing launched\n", per_cu); (void)hipGetLastError(); grid = -1; return; }
        grid = cus;
    }
    if (grid < 0) return;
    if (hipMemsetAsync((char*)d_ws + WS_CTL, 0, CTL_ZERO_BYTES, stream) != hipSuccess) return;
    Args a{};
    for (int i = 0; i < 17; ++i) a.in[i] = (const float*)d_in[i];
    a.out = (float*)d_out; a.ws = (unsigned char*)d_ws; a.mode = 7 | (31 << 8);
    for (int li = 0; li < N_LAUNCHES; ++li) {
        a.ph_lo = (N_LAUNCHES == PER_PHASE) ? li : 0; a.ph_hi = (N_LAUNCHES == PER_PHASE) ? li + 1 : PER_PHASE; a.li = li;
        for (int rep = 0; rep < ((N_LAUNCHES == PER_PHASE) ? NREP(li) : 1); ++rep) { a.mode = (rep == 0) ? (7 | (31 << 8)) : PROBE_MODE; hipLaunchKernelGGL(mk_fwd, dim3(grid), dim3(NWAVES * 64), LDS_BYTES, stream, a); }
        if (hipPeekAtLastError() != hipSuccess) { fprintf(stderr, "kernel_launch: launch %d failed\n", li); break; }
    }
}
```

```cpp
#include <hip/hip_runtime.h>
#include <cstdio>
#include <cstdint>
#include <cmath>

#ifndef MK_N_LAUNCHES
#define MK_N_LAUNCHES 1
#endif

namespace pg8 {
#define PG8_LAS __attribute__((address_space(3)))
typedef unsigned short bf16_t;
typedef short bf16x8 __attribute__((ext_vector_type(8)));
typedef float f32x4 __attribute__((ext_vector_type(4)));
typedef unsigned u32x4 __attribute__((ext_vector_type(4)));
typedef unsigned u32x2 __attribute__((ext_vector_type(2)));
constexpr int BM = 256, BK = 64, HALF = 128, HTB = HALF * BK * 2  , STAGE_BYTES = 8 * HTB, NXCD = 8, WGM = 8;

__host__ __device__ __forceinline__ int lds_byte(int r, int c) { const int st = (r >> 4) * 2 + (c >> 5), rr = r & 15, cc = c & 31, ob = rr * 64 + cc * 2; return st * 1024 + (ob ^ (((ob >> 9) & 1) << 5)); }
__host__ __device__ __forceinline__ void stage_rc(int b, int& R, int& C) { const int st = b / 1024, sb = b % 1024, swz = sb ^ (((sb >> 9) & 1) << 5); R = (st >> 1) * 16 + swz / 64; C = (st & 1) * 32 + (swz % 64) / 2; }
__host__ __device__ __forceinline__ int perm32(int rho) { const int n = rho >> 4, i = rho & 15; return 8 * (i >> 2) + 4 * n + (i & 3); }

struct Unit { int pm, pn; };
struct Gemm { const bf16_t* A; const bf16_t* Bt; int M, N, K; };

struct StaticOrder {
    int nM, nN, nwg, G, c, rev;
    __host__ __device__ void init(int M, int N, int G_, int c_, int rev_ = 0) { nM = M / BM; nN = N / BM; nwg = nM * nN; G = G_; c = c_; rev = rev_; }
    __host__ __device__ bool next(int i, Unit& u) const {
        const long L = (long)i * G + c; if (L >= nwg) return false;
        int wgid = (int)L; { const int q = nwg / NXCD, r = nwg % NXCD, xcd = wgid % NXCD, off = wgid / NXCD; wgid = (xcd < r ? xcd * (q + 1) : r * (q + 1) + (xcd - r) * q) + off; }
        const int nig = WGM * nN, gid = wgid / nig, fm = gid * WGM, gsz = (nM - fm) < WGM ? (nM - fm) : WGM;
        u.pm = fm + ((wgid % nig) % gsz); u.pn = (wgid % nig) / gsz; if (rev) u.pm = nM - 1 - u.pm; return true;
    }
    __device__ __forceinline__ void a_ready(const Unit&) const {}
    __device__ __forceinline__ void done(const Unit&) const {}
};
struct ListOrder {
    int n, c, pn0, pn1;
    __device__ bool next(int i, Unit& u) const { if (i != 0 || c >= n) return false; u.pm = 0; u.pn = (pn1 >= 0) ? (c == 0 ? pn0 : pn1) : (pn0 + c); return true; }
    __device__ __forceinline__ void a_ready(const Unit&) const {}
    __device__ __forceinline__ void done(const Unit&) const {}
};

__device__ __forceinline__ unsigned cvt_pk_bf16(float lo, float hi) { unsigned r; asm volatile("v_cvt_pk_bf16_f32 %0, %1, %2" : "=v"(r) : "v"(lo), "v"(hi)); return r; }
template <class Epi, class Sched, bool ALIGN_EPI = false, bool SP2 = false>
__device__ __forceinline__ void gemm_phase(PG8_LAS unsigned char* lds, const Gemm g, const Sched& S, const Epi& E) {
    const int tid = threadIdx.x, wid = __builtin_amdgcn_readfirstlane(tid >> 6), lane = tid & 63, wr = wid >> 2, wc = wid & 3, fr = lane & 15, fq = lane >> 4;
    const int K = g.K, nt = K / BK;
    unsigned voffA[2], voffB[2];
#pragma unroll
    for (int i = 0; i < 2; ++i) { int R, C; stage_rc(tid * 16 + i * 8192, R, C); const int Rb = Epi::PERM ? ((R & ~31) + perm32(R & 31)) : R;
        voffA[i] = (unsigned)(R * K + C) * 2u; voffB[i] = (unsigned)(Rb * K + C) * 2u; }
    const size_t kstep = (size_t)(BK * 2);
    const size_t hstep = (size_t)HALF * K * 2;
    const size_t tstep = 2 * hstep;
    const unsigned ldsw = (unsigned)wid * 1024u;
    const int aoff = lds_byte(wr * 64 + fr, fq * 8), boff = lds_byte(wc * 32 + fr, fq * 8);
#define PG8_SA(b, h) (((b) * 2 + (h)) * HTB)
#define PG8_SB(b, h) ((4 + (b) * 2 + (h)) * HTB)
#define PG8_STAGE(bufoff, gbase, voff) do { _Pragma("unroll") for (int _i = 0; _i < 2; ++_i) \
        __builtin_amdgcn_global_load_lds((const unsigned*)((const char*)(gbase) + (voff)[_i]), (PG8_LAS unsigned*)(lds + (bufoff) + ldsw + _i * 8192), 16, 0, 0); } while (0)
#define PG8_LDA(dst, b, h) do { _Pragma("unroll") for (int m = 0; m < 4; ++m) _Pragma("unroll") for (int k = 0; k < 2; ++k) dst[m][k] = *(const PG8_LAS bf16x8*)(lds + PG8_SA(b, h) + aoff + m * 2048 + k * 1024); } while (0)
#define PG8_LDB(dst, b, h) do { _Pragma("unroll") for (int n = 0; n < 2; ++n) _Pragma("unroll") for (int k = 0; k < 2; ++k) dst[n][k] = *(const PG8_LAS bf16x8*)(lds + PG8_SB(b, h) + boff + n * 2048 + k * 1024); } while (0)
#define PG8_MMA(ai, bj, At, Bt) do { __builtin_amdgcn_s_setprio(1); _Pragma("unroll") for (int m = 0; m < 4; ++m) _Pragma("unroll") for (int n = 0; n < 2; ++n) _Pragma("unroll") for (int k = 0; k < 2; ++k) \
        acc[ai][bj][m][n] = __builtin_amdgcn_mfma_f32_16x16x32_bf16(Bt[n][k], At[m][k], acc[ai][bj][m][n], 0, 0, 0); __builtin_amdgcn_s_setprio(0); } while (0)
#define PG8_WAIT_V(n) asm volatile("s_waitcnt vmcnt(" #n ")" ::: "memory")
#define PG8_WAIT_L(n) asm volatile("s_waitcnt lgkmcnt(" #n ")" ::: "memory")
#define PG8_BAR __builtin_amdgcn_s_barrier()
#define PG8_SCHED __builtin_amdgcn_sched_barrier(0)
    Unit cur, nxt; int ui = 0;
    if (!S.next(0, cur)) return;
    f32x4 acc[2][2][4][2];
#pragma unroll
    for (int a = 0; a < 2; ++a)
#pragma unroll
        for (int b = 0; b < 2; ++b)
#pragma unroll
            for (int m = 0; m < 4; ++m)
#pragma unroll
                for (int n = 0; n < 2; ++n) acc[a][b][m][n] = (f32x4){0.f, 0.f, 0.f, 0.f};
    bf16x8 At[4][2], B0[2][2], B1[2][2];
    const char* cA = (const char*)g.A + (size_t)cur.pm * tstep; const char* cB = (const char*)g.Bt + (size_t)cur.pn * tstep;
    S.a_ready(cur);
    if constexpr (SP2) {
        PG8_STAGE(PG8_SB(0, 0), cB, voffB); PG8_STAGE(PG8_SB(0, 1), cB + hstep, voffB); PG8_STAGE(PG8_SA(0, 0), cA, voffA); PG8_STAGE(PG8_SA(0, 1), cA + hstep, voffA);
        if (wr == 1) PG8_BAR;
        PG8_WAIT_V(2); PG8_BAR;
        PG8_STAGE(PG8_SB(1, 0), cB + kstep, voffB); PG8_STAGE(PG8_SA(1, 0), cA + kstep, voffA); PG8_STAGE(PG8_SB(1, 1), cB + hstep + kstep, voffB);
        PG8_WAIT_V(6); PG8_BAR;
    } else {
        PG8_STAGE(PG8_SB(0, 0), cB, voffB); PG8_STAGE(PG8_SA(0, 0), cA, voffA); PG8_STAGE(PG8_SB(0, 1), cB + hstep, voffB); PG8_STAGE(PG8_SA(0, 1), cA + hstep, voffA);
        if (wr == 1) PG8_BAR;
        PG8_WAIT_V(4); PG8_BAR;
        PG8_STAGE(PG8_SB(1, 0), cB + kstep, voffB); PG8_STAGE(PG8_SA(1, 0), cA + kstep, voffA); PG8_STAGE(PG8_SB(1, 1), cB + hstep + kstep, voffB);
        PG8_WAIT_V(6); PG8_BAR;
    }
    for (;;) {
        const bool has_next = S.next(ui + 1, nxt);
        const char* nA = has_next ? (const char*)g.A + (size_t)nxt.pm * tstep : cA; const char* nB = has_next ? (const char*)g.Bt + (size_t)nxt.pn * tstep : cB;
        for (int t = 0; t < nt; t += 2) {
            const bool last = (t == nt - 2);
            const char* a1 = cA + (size_t)(t + 1) * kstep;
            const char* a2 = last ? nA : cA + (size_t)(t + 2) * kstep; const char* b2 = last ? nB : cB + (size_t)(t + 2) * kstep;
            const char* a3 = a2 + kstep; const char* b3 = b2 + kstep;
            if (last && has_next) S.a_ready(nxt);
            if constexpr (SP2) {
            PG8_LDB(B0, 0, 0); PG8_LDB(B1, 0, 1); PG8_SCHED; PG8_LDA(At, 0, 0); PG8_STAGE(PG8_SA(1, 1), a1 + hstep, voffA);
            PG8_WAIT_V(8); PG8_WAIT_L(0); PG8_BAR; PG8_MMA(0, 0, At, B0); PG8_MMA(0, 1, At, B1); PG8_BAR; PG8_SCHED;
            PG8_LDA(At, 0, 1); PG8_STAGE(PG8_SB(0, 0), b2, voffB); PG8_STAGE(PG8_SB(0, 1), b2 + hstep, voffB); PG8_STAGE(PG8_SA(0, 0), a2, voffA);
            PG8_WAIT_V(8); PG8_WAIT_L(0); PG8_BAR; PG8_MMA(1, 0, At, B0); PG8_MMA(1, 1, At, B1); PG8_BAR; PG8_SCHED;
            PG8_LDB(B0, 1, 0); PG8_LDB(B1, 1, 1); PG8_SCHED; PG8_LDA(At, 1, 0); PG8_STAGE(PG8_SA(0, 1), a2 + hstep, voffA);
            PG8_WAIT_V(8); PG8_WAIT_L(0); PG8_BAR; PG8_MMA(0, 0, At, B0); PG8_MMA(0, 1, At, B1); PG8_BAR; PG8_SCHED;
            PG8_LDA(At, 1, 1); PG8_STAGE(PG8_SB(1, 0), b3, voffB); PG8_STAGE(PG8_SB(1, 1), b3 + hstep, voffB); PG8_STAGE(PG8_SA(1, 0), a3, voffA);
            PG8_WAIT_V(8); PG8_WAIT_L(0); PG8_BAR; PG8_MMA(1, 0, At, B0); PG8_MMA(1, 1, At, B1); PG8_BAR; PG8_SCHED;
            } else {
            PG8_LDB(B0, 0, 0); PG8_SCHED; PG8_LDA(At, 0, 0); PG8_STAGE(PG8_SA(1, 1), a1 + hstep, voffA);
            PG8_WAIT_L(8); PG8_BAR; PG8_WAIT_L(0); PG8_MMA(0, 0, At, B0); PG8_BAR; PG8_SCHED;
            PG8_LDB(B1, 0, 1); PG8_STAGE(PG8_SB(0, 0), b2, voffB);
            PG8_BAR; PG8_WAIT_L(0); PG8_MMA(0, 1, At, B1); PG8_BAR;
            PG8_LDA(At, 0, 1); PG8_STAGE(PG8_SA(0, 0), a2, voffA);
            PG8_BAR; PG8_WAIT_L(0); PG8_MMA(1, 0, At, B0); PG8_BAR; PG8_SCHED;
            PG8_STAGE(PG8_SB(0, 1), b2 + hstep, voffB);
            PG8_WAIT_V(6); PG8_BAR; PG8_MMA(1, 1, At, B1); PG8_BAR;
            PG8_LDB(B0, 1, 0); PG8_SCHED; PG8_LDA(At, 1, 0); PG8_STAGE(PG8_SA(0, 1), a2 + hstep, voffA);
            PG8_WAIT_L(8); PG8_BAR; PG8_WAIT_L(0); PG8_MMA(0, 0, At, B0); PG8_BAR; PG8_SCHED;
            PG8_LDB(B1, 1, 1); PG8_STAGE(PG8_SB(1, 0), b3, voffB);
            PG8_BAR; PG8_WAIT_L(0); PG8_MMA(0, 1, At, B1); PG8_BAR;
            PG8_LDA(At, 1, 1); PG8_STAGE(PG8_SA(1, 0), a3, voffA);
            PG8_BAR; PG8_WAIT_L(0); PG8_MMA(1, 0, At, B0); PG8_BAR; PG8_SCHED;
            PG8_STAGE(PG8_SB(1, 1), b3 + hstep, voffB);
            PG8_WAIT_V(6); PG8_BAR; PG8_MMA(1, 1, At, B1); PG8_BAR;
            }
        }
        if constexpr (ALIGN_EPI) { if (wr == 0) PG8_BAR; }
        if constexpr (!Epi::AFTER_DRAIN) { E(acc, cur, wr, wc, fr, fq); S.done(cur); }
        if (!has_next) break;
#pragma unroll
        for (int a = 0; a < 2; ++a)
#pragma unroll
            for (int b = 0; b < 2; ++b)
#pragma unroll
                for (int m = 0; m < 4; ++m)
#pragma unroll
                    for (int n = 0; n < 2; ++n) acc[a][b][m][n] = (f32x4){0.f, 0.f, 0.f, 0.f};
        cur = nxt; cA = nA; cB = nB; ++ui;
        if constexpr (ALIGN_EPI) { if (wr == 1) PG8_BAR; }
    }
    PG8_WAIT_V(0);
    if constexpr (!ALIGN_EPI) { if (wr == 0) PG8_BAR; }
    PG8_BAR;
    if constexpr (Epi::AFTER_DRAIN) { E.fused(acc, cur, wr, wc, fr, fq, lds, wid, lane); S.done(cur); }
#undef PG8_SA
#undef PG8_SB
#undef PG8_STAGE
#undef PG8_LDA
#undef PG8_LDB
#undef PG8_MMA
#undef PG8_WAIT_V
#undef PG8_WAIT_L
#undef PG8_BAR
#undef PG8_SCHED
}
}

constexpr int BATCH = 8, SEQ = 4096, DM = 1024, FF = 2816, NMETA = 16;
constexpr int MR = BATCH * SEQ;
constexpr int NKV = SEQ + 128;
constexpr int NIN = 3840;
constexpr float EPS = 1e-6f;
constexpr float LOG2E = 1.4426950408889634f;
constexpr float QSCALE = 0.125f * LOG2E;
constexpr float IDX_SCALE = 0.0625f;

namespace epi {
using pg8::f32x4; using pg8::u32x2; using pg8::Unit; using pg8::bf16_t; using pg8::cvt_pk_bf16;
typedef _Float16 f16x2 __attribute__((ext_vector_type(2)));

__device__ __forceinline__ float row_rs(const float* ssq, int row) {
    const f32x4* p = (const f32x4*)(ssq + (size_t)row * 16); const f32x4 a = p[0], b = p[1], c = p[2], d = p[3];
    const float s = (((a[0] + a[1]) + (a[2] + a[3])) + ((b[0] + b[1]) + (b[2] + b[3]))) + (((c[0] + c[1]) + (c[2] + c[3])) + ((d[0] + d[1]) + (d[2] + d[3])));
    return __builtin_amdgcn_rsqf(s * (1.0f / 1024.0f) + EPS);
}
__device__ __forceinline__ void row_rs_wave(const float* ssq, int base, int fr, float (&rs)[2][4]) {
    const int L = (int)(threadIdx.x & 63u); const float r0 = row_rs(ssq, base + L), r1 = row_rs(ssq, base + 128 + L);
#pragma unroll
    for (int m = 0; m < 4; ++m) { rs[0][m] = __shfl(r0, m * 16 + fr); rs[1][m] = __shfl(r1, m * 16 + fr); }
}
__device__ __forceinline__ float sigmoidf_fast(float x) { return __builtin_amdgcn_rcpf(1.0f + __builtin_amdgcn_exp2f(-x * LOG2E)); }
__device__ __forceinline__ u32x2 pack4(const f32x4 v) { u32x2 w; w.x = cvt_pk_bf16(v[0], v[1]); w.y = cvt_pk_bf16(v[2], v[3]); return w; }
__device__ __forceinline__ unsigned pk_f16(float lo, float hi) { f16x2 h; h.x = (_Float16)lo; h.y = (_Float16)hi; return __builtin_bit_cast(unsigned, h); }
__device__ __forceinline__ u32x2 pack4h(const f32x4 v) { u32x2 w; w.x = pk_f16(v[0], v[1]); w.y = pk_f16(v[2], v[3]); return w; }
__device__ __forceinline__ f32x4 unpack4(const u32x2 w) { f32x4 v; v[0] = __uint_as_float(w.x << 16); v[1] = __uint_as_float(w.x & 0xffff0000u); v[2] = __uint_as_float(w.y << 16); v[3] = __uint_as_float(w.y & 0xffff0000u); return v; }


struct EpiGateUp {
    static constexpr bool PERM = false, AFTER_DRAIN = false;
    bf16_t* H; const float* ssq;
    __device__ __forceinline__ void operator()(const f32x4 (&acc)[2][2][4][2], const Unit& u, int wr, int wc, int fr, int fq) const {
        float rsw[2][4]; row_rs_wave(ssq, u.pm * 256 + wr * 64, fr, rsw);
#pragma unroll
        for (int ai = 0; ai < 2; ++ai)
#pragma unroll
            for (int m = 0; m < 4; ++m) {
                const int row = u.pm * 256 + ai * 128 + wr * 64 + m * 16 + fr; const float rs = rsw[ai][m];
                bf16_t* hp = H + (size_t)row * FF + u.pn * 128 + wc * 16 + fq * 4;
#pragma unroll
                for (int bj = 0; bj < 2; ++bj) { const f32x4 g = acc[ai][bj][m][0] * rs, up = acc[ai][bj][m][1] * rs; f32x4 h;
#pragma unroll
                    for (int e = 0; e < 4; ++e) h[e] = g[e] * sigmoidf_fast(g[e]) * up[e];
                    *(u32x2*)(hp + bj * 64) = pack4(h); }
            }
    }
};

struct EpiResid {
    static constexpr bool PERM = false, AFTER_DRAIN = false;
    const float* res; float* out; bf16_t* xb; float* ssq; float alpha;
    __device__ __forceinline__ void operator()(const f32x4 (&acc)[2][2][4][2], const Unit& u, int wr, int wc, int fr, int fq) const {
#pragma unroll
        for (int ai = 0; ai < 2; ++ai)
#pragma unroll
            for (int m = 0; m < 4; ++m) {
                const int row = u.pm * 256 + ai * 128 + wr * 64 + m * 16 + fr; const size_t off = (size_t)row * DM + u.pn * 256 + wc * 32 + fq * 4; float q = 0.f;
#pragma unroll
                for (int bj = 0; bj < 2; ++bj)
#pragma unroll
                    for (int n = 0; n < 2; ++n) { const size_t o2 = off + bj * 128 + n * 16; const f32x4 r = *(const f32x4*)(res + o2); const f32x4 o = r + acc[ai][bj][m][n] * alpha;
                        *(f32x4*)(out + o2) = o; q += (o[0] * o[0] + o[1] * o[1]) + (o[2] * o[2] + o[3] * o[3]);
                        if (xb) *(u32x2*)(xb + o2) = pack4(o); }
                q += __shfl_xor(q, 16); q += __shfl_xor(q, 32);
                if (fq == 0) ssq[(size_t)row * 16 + u.pn * 4 + wc] = q;
            }
    }
};

template <bool SECOND> struct EpiBranch {
    static constexpr bool PERM = false, AFTER_DRAIN = false;
    const bf16_t* sg; bf16_t* t1; bf16_t* outp;
    __device__ __forceinline__ void operator()(const f32x4 (&acc)[2][2][4][2], const Unit& u, int wr, int wc, int fr, int fq) const {
#pragma unroll
        for (int ai = 0; ai < 2; ++ai)
#pragma unroll
            for (int m = 0; m < 4; ++m) {
                const int row = u.pm * 256 + ai * 128 + wr * 64 + m * 16 + fr; const size_t off = (size_t)row * DM + u.pn * 256 + wc * 32 + fq * 4;
#pragma unroll
                for (int bj = 0; bj < 2; ++bj)
#pragma unroll
                    for (int n = 0; n < 2; ++n) { const size_t o2 = off + bj * 128 + n * 16; const f32x4 g = unpack4(*(const u32x2*)(sg + o2)); f32x4 o = g * acc[ai][bj][m][n];
                        if (SECOND) o = o + unpack4(*(const u32x2*)(t1 + o2));
                        *(u32x2*)((SECOND ? outp : t1) + o2) = pack4(o); }
            }
    }
};

struct EpiInProj {
    static constexpr bool PERM = false, AFTER_DRAIN = false;
    const float* ssq; const float* cosT; const float* sinT;
    bf16_t *QA, *KA, *VA, *QS, *KS, *VS, *SGA, *SGB; unsigned short *QI, *KI; float* WI; int meta;
    template <int MODE  > static __device__ __forceinline__ void rope_store(unsigned short* d, const f32x4 x1, const f32x4 x2, const f32x4 c, const f32x4 s, float sc) {
        const f32x4 o1 = (x1 * c - x2 * s) * sc, o2 = (x2 * c + x1 * s) * sc;
        if (MODE == 0) { *(u32x2*)d = pack4(o1); *(u32x2*)(d + 32) = pack4(o2); } else { *(u32x2*)d = pack4h(o1); *(u32x2*)(d + 32) = pack4h(o2); }
    }
    __device__ __forceinline__ void operator()(const f32x4 (&acc)[2][2][4][2], const Unit& u, int wr, int wc, int fr, int fq) const {
        const int pn = u.pn, g = wc & 1, hq = wc >> 1;
        float rsw[2][4]; row_rs_wave(ssq, u.pm * 256 + wr * 64, fr, rsw);
#pragma unroll
        for (int ai = 0; ai < 2; ++ai)
#pragma unroll
            for (int m = 0; m < 4; ++m) {
                const int rloc = ai * 128 + wr * 64 + m * 16 + fr, row = u.pm * 256 + rloc;
                if (meta && (ai | wr | m)) continue;
                const float rs = rsw[ai][m];
                int pos, krow; if (!meta) { const int b = row >> 12, t = row & 4095; pos = 16 + t; krow = b * NKV + 128 + t; } else { pos = rloc; krow = 112 + rloc; }
                const int nrep = meta ? BATCH : 1;
                if (pn < 7) {
                    const f32x4 c4 = *(const f32x4*)(cosT + pos * 32 + 16 * g + 4 * fq), s4 = *(const f32x4*)(sinT + pos * 32 + 16 * g + 4 * fq);
                    const int i0 = 16 * g + 4 * fq;
#pragma unroll
                    for (int bj = 0; bj < 2; ++bj) {
                        const f32x4 v0 = acc[ai][bj][m][0] * rs, v1 = acc[ai][bj][m][1] * rs;
                        if (pn <= 1) { if (!meta) rope_store<0>(QA + (size_t)row * 512 + (pn * 4 + bj * 2 + hq) * 64 + i0, v0, v1, c4, s4, QSCALE); }
                        else if (pn == 3) { if (!meta) rope_store<1>(QI + (size_t)row * 256 + (bj * 2 + hq) * 64 + i0, v0, v1, c4, s4, 1.0f); }
                        else if (pn <= 5 && pn >= 4) { if (!meta) rope_store<0>(QS + (size_t)row * 512 + ((pn - 4) * 4 + bj * 2 + hq) * 64 + i0, v0, v1, c4, s4, QSCALE); }
                        else if (pn == 2) {
                            for (int rep = 0; rep < nrep; ++rep) { const size_t kr = (size_t)krow + (size_t)rep * NKV;
                                if (bj == 0) { if (wc < 2) rope_store<0>(KA + kr * 64 + i0, v0, v1, c4, s4, 1.0f);
                                               else { bf16_t* d = VA + kr * 64 + 32 * (wc - 2) + 4 * fq; *(u32x2*)d = pack4(v0); *(u32x2*)(d + 16) = pack4(v1); } }
                                else if (wc < 2) rope_store<1>(KI + kr * 64 + i0, v0, v1, c4, s4, 1.0f); }
                            if (bj == 1 && wc == 2 && fq == 0 && !meta) *(f32x4*)(WI + (size_t)row * 4) = v0 * IDX_SCALE;
                        } else {
                            for (int rep = 0; rep < nrep; ++rep) { const size_t kr = (size_t)krow + (size_t)rep * NKV;
                                if (bj == 0) rope_store<0>(KS + kr * 128 + hq * 64 + i0, v0, v1, c4, s4, 1.0f);
                                else { bf16_t* d = VS + kr * 128 + 32 * wc + 4 * fq; *(u32x2*)d = pack4(v0); *(u32x2*)(d + 16) = pack4(v1); } }
                        }
                    }
                } else if (!meta) {
                    bf16_t* d = (pn < 11 ? SGA + (size_t)(pn - 7) * 256 : SGB + (size_t)(pn - 11) * 256) + (size_t)row * DM + wc * 32 + fq * 4;
#pragma unroll
                    for (int bj = 0; bj < 2; ++bj)
#pragma unroll
                        for (int n = 0; n < 2; ++n) { const f32x4 v = acc[ai][bj][m][n] * rs; f32x4 o;
#pragma unroll
                            for (int e = 0; e < 4; ++e) o[e] = sigmoidf_fast(v[e]);
                            *(u32x2*)(d + bj * 128 + n * 16) = pack4(o); }
                }
            }
    }
};
}

namespace att {
#define ALAS __attribute__((address_space(3)))
typedef _Float16 f16x8 __attribute__((ext_vector_type(8)));
typedef short bf16x8 __attribute__((ext_vector_type(8)));
typedef short s16x4 __attribute__((ext_vector_type(4)));
typedef float f32x16 __attribute__((ext_vector_type(16)));
typedef float f32x4 __attribute__((ext_vector_type(4)));
typedef unsigned u32x4 __attribute__((ext_vector_type(4)));
typedef unsigned u32x2 __attribute__((ext_vector_type(2)));
typedef unsigned short u16;

constexpr int HSTRIDE = 767, HMID = 360;
constexpr int CAND_CAP = 380, CSTRIDE = 381;
constexpr int L_KST = 32 * HSTRIDE * 4;
constexpr int L_MASK = 131072, MASK_W = 136;
constexpr int L_QINFO = L_MASK + 32 * MASK_W * 4;
constexpr int L_WSF = L_QINFO + 512;
constexpr int L_TRASH = L_WSF + 8 * 64 * 4;
constexpr int L_END = L_TRASH + 8 * 64 * 8;
constexpr int L_KBUF = 0, L_VBUF = 32768, L_OST = 65536;
static_assert(L_KST % 16 == 0 && L_KST + 8 * 4096 <= L_MASK && 32 * CSTRIDE * 8 <= L_KST, "selection LDS map");

__device__ __forceinline__ int crow(int r, int hi) { return (r & 3) + 8 * (r >> 2) + 4 * hi; }
__device__ __forceinline__ unsigned swap_or(unsigned w) { auto rr = __builtin_amdgcn_permlane32_swap(w, w, false, false); return rr[0] | rr[1]; }
__device__ __forceinline__ float max2_s(float a, float b) { float r; asm("v_max_f32_e32 %0, %1, %2" : "=v"(r) : "v"(a), "v"(b)); return r; }
__device__ __forceinline__ float max3_s(float a, float b, float c) { float r; asm("v_max3_f32 %0, %1, %2, %3" : "=v"(r) : "v"(a), "v"(b), "v"(c)); return r; }
__device__ __forceinline__ unsigned bfe1_s(unsigned w, int pos) { unsigned r; asm("v_bfe_i32 %0, %1, %2, 1" : "=v"(r) : "v"(w), "n"(pos)); return r; }
__device__ __forceinline__ float relu_s(float a) { const int i = (int)__float_as_uint(a); return __uint_as_float((unsigned)(i > 0 ? i : 0)); }
__device__ __forceinline__ float swap_max(float m) { auto rr = __builtin_amdgcn_permlane32_swap(__float_as_uint(m), __float_as_uint(m), false, false); return max2_s(__uint_as_float(rr[0]), __uint_as_float(rr[1])); }
__device__ __forceinline__ float swap_add(float m) { auto rr = __builtin_amdgcn_permlane32_swap(__float_as_uint(m), __float_as_uint(m), false, false); return __uint_as_float(rr[0]) + __uint_as_float(rr[1]); }

__device__ __forceinline__ float idx_score(const f32x4 w, float d0, float d1, float d2, float d3) {
    float sc = fmaf(w[0], relu_s(d0), 0.0f); sc = fmaf(w[1], relu_s(d1), sc); sc = fmaf(w[2], relu_s(d2), sc); return fmaf(w[3], relu_s(d3), sc);
}
__device__ __forceinline__ int idx_bin(unsigned bits) {
    int t = (int)__builtin_amdgcn_ubfe(bits, 19, 12) - 1774; t = t < 1 ? 1 : (t > 354 ? 354 : t);
    const int bin = t ^ ((int)bits >> 31);
    return bits ? bin : 0;
}

template <int PASS, bool EDGE> __device__ __forceinline__ void select_block(ALAS unsigned char* lds, const f32x16& a0, const f32x16& a1, const f32x16& a2, const f32x16& a3, const f32x4 w4,
                                                                          int kb, int sq, int r32, int hi, int binstar, int wid, int lane, int steps) {
    ALAS unsigned* hist = (ALAS unsigned*)lds;
    if (PASS == 0) {
        const unsigned hb = (unsigned)(size_t)(hist + r32 * HSTRIDE + HMID);
#pragma unroll
        for (int r0 = 0; r0 < 16; r0 += 4) {
            float sc[4]; int bin[4];
#pragma unroll
            for (int i = 0; i < 4; ++i) sc[i] = idx_score(w4, a0[r0 + i], a1[r0 + i], a2[r0 + i], a3[r0 + i]);
#pragma unroll
            for (int i = 0; i < 4; ++i) bin[i] = idx_bin(__float_as_uint(sc[i]));
#pragma unroll
            for (int i = 0; i < 4; ++i) { unsigned inc = 1u; if (EDGE) { const int s = kb * 32 + crow(r0 + i, hi); inc = ((s >= 112) && (s <= sq)) ? 1u : 0u; }
                if (steps & 64) asm volatile("" :: "v"(bin[i]), "v"(inc)); else __hip_atomic_fetch_add((ALAS unsigned*)(size_t)(hb + (unsigned)(bin[i] << 2)), inc, __ATOMIC_RELAXED, __HIP_MEMORY_SCOPE_WORKGROUP); }
        }
    } else {
        ALAS unsigned* qinfo = (ALAS unsigned*)(lds + L_QINFO);
        const unsigned cb = (unsigned)(size_t)(lds + r32 * (CSTRIDE * 8)), tb = (unsigned)(size_t)(lds + L_TRASH + wid * 512 + lane * 8);
        const bool zb = (binstar == 0);
        unsigned wsel = 0u, wz = 0u;
#pragma unroll
        for (int g8 = 1; g8 >= 0; --g8) {
            unsigned slot[8], key[8]; unsigned weq = 0u;
#pragma unroll
            for (int h4 = 1; h4 >= 0; --h4) {
                float sc[4]; int bin[4];
#pragma unroll
                for (int i = 3; i >= 0; --i) { const int r = g8 * 8 + h4 * 4 + i; sc[i] = idx_score(w4, a0[r], a1[r], a2[r], a3[r]); }
#pragma unroll
                for (int i = 3; i >= 0; --i) { const unsigned bits = __float_as_uint(sc[i]); bin[i] = idx_bin(bits); key[h4 * 4 + i] = bits ^ ((unsigned)((int)bits >> 31) | 0x80000000u); }
#pragma unroll
                for (int i = 3; i >= 0; --i) { const int r = g8 * 8 + h4 * 4 + i;
                    bool sel = bin[i] > binstar, eq = bin[i] == binstar;
                    if (EDGE) { const int s = kb * 32 + crow(r, hi); const bool valid = (s >= 112) && (s <= sq); sel = sel && valid; eq = eq && valid; }
                    wsel = wsel + wsel + (sel ? 1u : 0u); weq = weq + weq + (eq ? 1u : 0u);
                    slot[h4 * 4 + i] = __hip_atomic_fetch_add(qinfo + r32 * 4 + 2, (eq && !zb) ? 1u : 0u, __ATOMIC_RELAXED, __HIP_MEMORY_SCOPE_WORKGROUP); }
            }
            wz = (wz << 8) | weq;
#pragma unroll
            for (int rr = 0; rr < 8; ++rr) { const int r = g8 * 8 + rr;
                const bool eq = ((weq >> rr) & 1u) && !zb; const unsigned sl = slot[rr] < (unsigned)CAND_CAP ? slot[rr] : (unsigned)CAND_CAP;
                const unsigned addr = eq ? cb + sl * 8u : tb;
                u32x2 e; e.x = ~(unsigned)(kb * 32 + crow(r, hi)); e.y = key[rr];
                *(ALAS u32x2*)(size_t)addr = e;
            }
        }
        unsigned word = (wsel & 0xfu) | ((wsel & 0xf0u) << 4) | ((wsel & 0xf00u) << 8) | ((wsel & 0xf000u) << 12);
        word = swap_or(word << (4 * hi));
        if (hi == 0) ((ALAS unsigned*)(lds + L_MASK))[r32 * MASK_W + kb] = word;
        unsigned wordz = (wz & 0xfu) | ((wz & 0xf0u) << 4) | ((wz & 0xf00u) << 8) | ((wz & 0xf000u) << 12);
        wordz = swap_or(wordz << (4 * hi));
        if (hi == 0 && zb) ((ALAS unsigned*)(lds + r32 * (CSTRIDE * 8)))[kb] = wordz;
    }
}

template <int PASS> __device__ __forceinline__ void select_pass(ALAS unsigned char* lds, int b, int qt, const f16x8 (&qf)[4][4], const f32x4 w4, const u16* KI, int sq, int r32, int hi, int wid, int lane, int steps) {
    int binstar = 0; if (PASS) binstar = (int)((ALAS unsigned*)(lds + L_QINFO))[r32 * 4 + 0];
    const int kb_last = 4 + qt;
    const u16* kbase = KI + (size_t)b * NKV * 64 + lane * 8;
    ALAS unsigned char* kst = lds + L_KST + wid * 4096;
    const int wrow = lane >> 3, wch = lane & 7;
    const int woff = wrow * 128 + ((wch ^ wrow) << 4);
    const int roff = r32 * 128;
    int kb = 3 + wid;
    u32x4 g[4];
    f16x8 kf[4];
    if (kb <= kb_last) {
#pragma unroll
        for (int j = 0; j < 4; ++j) g[j] = *(const u32x4*)(kbase + (size_t)kb * 2048 + j * 512);
#pragma unroll
        for (int j = 0; j < 4; ++j) *(ALAS u32x4*)(kst + j * 1024 + woff) = g[j];
#pragma unroll
        for (int ks = 0; ks < 4; ++ks) kf[ks] = *(ALAS const f16x8*)(kst + roff + ((((ks << 1) | hi) ^ (r32 & 7)) << 4));
    }
    for (; kb <= kb_last; kb += 8) {
        const bool more = kb + 8 <= kb_last;
        if (more) {
#pragma unroll
            for (int j = 0; j < 4; ++j) g[j] = *(const u32x4*)(kbase + (size_t)(kb + 8) * 2048 + j * 512); }
        f32x16 a0 = {}, a1 = {}, a2 = {}, a3 = {};
#pragma unroll
        for (int ks = 0; ks < 4; ++ks) {
            a0 = __builtin_amdgcn_mfma_f32_32x32x16_f16(kf[ks], qf[0][ks], a0, 0, 0, 0);
            a1 = __builtin_amdgcn_mfma_f32_32x32x16_f16(kf[ks], qf[1][ks], a1, 0, 0, 0);
            a2 = __builtin_amdgcn_mfma_f32_32x32x16_f16(kf[ks], qf[2][ks], a2, 0, 0, 0);
            a3 = __builtin_amdgcn_mfma_f32_32x32x16_f16(kf[ks], qf[3][ks], a3, 0, 0, 0);
        }
        if (kb == 3 || kb == kb_last) select_block<PASS, true>(lds, a0, a1, a2, a3, w4, kb, sq, r32, hi, binstar, wid, lane, steps);
        else select_block<PASS, false>(lds, a0, a1, a2, a3, w4, kb, sq, r32, hi, binstar, wid, lane, steps);
        if (more) {
#pragma unroll
            for (int j = 0; j < 4; ++j) *(ALAS u32x4*)(kst + j * 1024 + woff) = g[j];
#pragma unroll
            for (int ks = 0; ks < 4; ++ks) kf[ks] = *(ALAS const f16x8*)(kst + roff + ((((ks << 1) | hi) ^ (r32 & 7)) << 4));
        }
    }
}

__device__ __forceinline__ void select_unit(ALAS unsigned char* lds, int b, int qt, const u16* QI, const u16* KI, const float* WI, unsigned* err, int steps) {
    int tid = threadIdx.x; asm volatile("" : "+v"(tid));
    const int lane = tid & 63, r32 = lane & 31, hi = lane >> 5; const int wid = __builtin_amdgcn_readfirstlane(tid >> 6);
    ALAS unsigned* hist = (ALAS unsigned*)lds;
    ALAS unsigned* maskw = (ALAS unsigned*)(lds + L_MASK);
    ALAS unsigned* qinfo = (ALAS unsigned*)(lds + L_QINFO);
    { const u32x4 zero = {0u, 0u, 0u, 0u};
      ALAS u32x4* z = (ALAS u32x4*)lds; for (int i = tid; i < (32 * HSTRIDE * 4 + 15) / 16; i += 512) z[i] = zero;
      ALAS u32x4* z2 = (ALAS u32x4*)(lds + L_MASK); for (int i = tid; i < (L_WSF - L_MASK) / 16; i += 512) z2[i] = zero; }
    const size_t row0 = (size_t)b * SEQ + 32 * qt;
    f16x8 qf[4][4];
#pragma unroll
    for (int h = 0; h < 4; ++h)
#pragma unroll
        for (int ks = 0; ks < 4; ++ks) qf[h][ks] = *(const f16x8*)(QI + (row0 + r32) * 256 + h * 64 + ks * 16 + hi * 8);
    const f32x4 w4 = *(const f32x4*)(WI + (row0 + r32) * 4);
    const int sq = 128 + 32 * qt + r32;
    __syncthreads();
    if (steps & 2) select_pass<0>(lds, b, qt, qf, w4, KI, sq, r32, hi, wid, lane, steps);
    __syncthreads();
    if (steps & 4) for (int qq = 0; qq < 4; ++qq) {
        const int q = wid * 4 + qq; int kq = 32 * qt + q + 17; kq = kq > 256 ? 256 : kq;
        const ALAS unsigned* hp = hist + q * HSTRIDE + lane * 12;
        unsigned sum = 0u;
#pragma unroll
        for (int i = 0; i < 12; ++i) sum += (lane * 12 + i < HSTRIDE) ? hp[i] : 0u;
        unsigned I = sum;
#pragma unroll
        for (int o = 1; o < 64; o <<= 1) { const unsigned y = __shfl_down(I, o); if (lane + o < 64) I += y; }
        const unsigned above = I - sum; const bool hit = (I >= (unsigned)kq) && (above < (unsigned)kq);
        const unsigned long long bal = __ballot(hit);
        const int lstar = bal ? (__ffsll((long long)bal) - 1) : 0;
        const unsigned aboveS = __shfl(above, lstar);
        unsigned c = 0u; if (lane < 12 && lstar * 12 + lane < HSTRIDE) c = hist[q * HSTRIDE + lstar * 12 + lane];
        unsigned I2 = c;
#pragma unroll
        for (int o = 1; o < 16; o <<= 1) { const unsigned y = __shfl_down(I2, o); if (lane + o < 64) I2 += y; }
        const bool hit2 = (lane < 12) && (aboveS + I2 >= (unsigned)kq) && (aboveS + I2 - c < (unsigned)kq);
        if (hit2) { qinfo[q * 4 + 0] = (unsigned)(lstar * 12 + lane - HMID); qinfo[q * 4 + 1] = aboveS + I2 - c; qinfo[q * 4 + 3] = (unsigned)kq; }
    }
    __syncthreads();
    for (int qq = 0; qq < 4; ++qq) { const int q = wid * 4 + qq;
        if ((int)qinfo[q * 4 + 0] == 0) { ALAS unsigned* z = (ALAS unsigned*)(lds + q * (CSTRIDE * 8)); z[lane] = 0u; z[64 + lane] = 0u; if (lane < MASK_W - 128) z[128 + lane] = 0u; } }
    __syncthreads();
    if (steps & 8) select_pass<1>(lds, b, qt, qf, w4, KI, sq, r32, hi, wid, lane, steps);
    __syncthreads();
    if (steps & 16) for (int qq = 0; qq < 4; ++qq) {
        const int q = wid * 4 + qq; const unsigned nraw = qinfo[q * 4 + 2]; int n = nraw > (unsigned)CAND_CAP ? CAND_CAP : (int)nraw; if ((steps & 32) && n > 64) n = 64;
        const int rneed = (int)qinfo[q * 4 + 3] - (int)qinfo[q * 4 + 1];
        if (nraw > (unsigned)CAND_CAP && lane == 0) atomicOr(err, 2u);
        const ALAS unsigned long long* cl = (const ALAS unsigned long long*)(lds + q * (CSTRIDE * 8));
        const int bs = (int)qinfo[q * 4 + 0], bidx = bs < 0 ? ~bs : bs;
        const bool regular = (bidx > 1) && (bidx < 354);
        if (bs == 0) {
            ALAS unsigned* z = (ALAS unsigned*)(lds + q * (CSTRIDE * 8)); int base = 0;
            for (int c = 0; c < 3; ++c) {
                const int wi = c * 64 + lane; const unsigned w = (wi < MASK_W) ? z[wi] : 0u; const int cnt = __popc(w);
                int P = cnt;
#pragma unroll
                for (int o = 1; o < 64; o <<= 1) { const int y = __shfl_up(P, o); if (lane >= o) P += y; }
                const int need = rneed - (base + P - cnt); unsigned take = 0u;
                if (need >= cnt) take = w; else if (need > 0) { unsigned t = w; for (int i = 0; i < need; ++i) { take |= t & (0u - t); t &= t - 1u; } }
                if (take) maskw[q * MASK_W + wi] |= take;
                base += __shfl(P, 63);
            }
        } else if (n <= 64) {
            const unsigned long long me = (lane < n) ? cl[lane] : 0ull;
            unsigned long long pre = 0x00000000FFFFE000ull; int bit = 63;
            if (regular) { const unsigned long long k0 = cl[0]; pre |= (k0 & 0xFFF8000000000000ull); bit = 50; }
            if (rneed < n) for (;;) { const unsigned long long t = pre | (1ull << bit); const int cnt = __popcll(__ballot(me >= t));
                if (cnt >= rneed) pre = t; if (cnt == rneed) break;
                if (bit == 32) bit = 12; else if (bit == 0) break; else --bit; }
            if (me >= pre && lane < n) { const unsigned s = ~(unsigned)me; __hip_atomic_fetch_or(maskw + q * MASK_W + (s >> 5), 1u << (s & 31u), __ATOMIC_RELAXED, __HIP_MEMORY_SCOPE_WORKGROUP); }
        } else {
            unsigned long long me[8];
#pragma unroll
            for (int c = 0; c < 8; ++c) me[c] = (c * 64 + lane < n) ? cl[c * 64 + lane] : 0ull;
            const int nch = (n + 63) >> 6;
            unsigned long long pre = 0x00000000FFFFE000ull; int bit = 63;
            if (regular) { const unsigned long long k0 = cl[0]; pre |= (k0 & 0xFFF8000000000000ull); bit = 50; }
            if (rneed < n) for (;;) { const unsigned long long t = pre | (1ull << bit); int cnt = 0;
#pragma unroll
                for (int c = 0; c < 8; ++c) if (c < nch) cnt += __popcll(__ballot(me[c] >= t));
                if (cnt >= rneed) pre = t; if (cnt == rneed) break;
                if (bit == 32) bit = 12; else if (bit == 0) break; else --bit; }
#pragma unroll
            for (int c = 0; c < 8; ++c) if (c < nch && me[c] >= pre) { const unsigned s = ~(unsigned)me[c]; __hip_atomic_fetch_or(maskw + q * MASK_W + (s >> 5), 1u << (s & 31u), __ATOMIC_RELAXED, __HIP_MEMORY_SCOPE_WORKGROUP); }
        }
    }
    __syncthreads();
}

__device__ __forceinline__ void pv(f32x16* o, int vb, bf16x8 pa0, bf16x8 pa1, bf16x8 pa2, bf16x8 pa3) {
#pragma unroll
    for (int d0 = 0; d0 < 2; ++d0) { s16x4 lo[4], hi[4];
#pragma unroll
        for (int ks = 0; ks < 4; ++ks) {
            asm volatile("ds_read_b64_tr_b16 %0,%1 offset:%c2" : "=&v"(lo[ks]) : "v"(vb), "i"(d0 * 4096 + ks * 1024) : "memory");
            asm volatile("ds_read_b64_tr_b16 %0,%1 offset:%c2" : "=&v"(hi[ks]) : "v"(vb), "i"(d0 * 4096 + ks * 1024 + 512) : "memory"); }
        asm volatile("s_waitcnt lgkmcnt(0)" ::: "memory"); __builtin_amdgcn_sched_barrier(0);
#define ATT_PK(k) (bf16x8){lo[k][0], lo[k][1], lo[k][2], lo[k][3], hi[k][0], hi[k][1], hi[k][2], hi[k][3]}
        o[d0] = __builtin_amdgcn_mfma_f32_32x32x16_bf16(pa0, ATT_PK(0), o[d0], 0, 0, 0);
        o[d0] = __builtin_amdgcn_mfma_f32_32x32x16_bf16(pa1, ATT_PK(1), o[d0], 0, 0, 0);
        o[d0] = __builtin_amdgcn_mfma_f32_32x32x16_bf16(pa2, ATT_PK(2), o[d0], 0, 0, 0);
        o[d0] = __builtin_amdgcn_mfma_f32_32x32x16_bf16(pa3, ATT_PK(3), o[d0], 0, 0, 0);
#undef ATT_PK
    }
}

template <bool SWA> __device__ __forceinline__ void attn_unit(ALAS unsigned char* lds, int b, int qt, const u16* Q, const u16* K, const u16* V, u16* O, float sink2) {
    constexpr int KP = SWA ? 128 : 64, NH = SWA ? 2 : 1;
    int tid = threadIdx.x; asm volatile("" : "+v"(tid));
    const int lane = tid & 63, r32 = lane & 31, hi = lane >> 5; const int wid = __builtin_amdgcn_readfirstlane(tid >> 6);
    const int kvh = SWA ? (wid >> 2) : 0;
    const size_t row0 = (size_t)b * SEQ + 32 * qt;
    bf16x8 qr[4];
#pragma unroll
    for (int d0 = 0; d0 < 4; ++d0) qr[d0] = *(const bf16x8*)(Q + (row0 + r32) * 512 + wid * 64 + d0 * 16 + hi * 8);
    const int sq = 128 + 32 * qt + r32;
    const int j_lo = SWA ? (qt >> 1) : 1, j_hi = (qt >> 1) + 2;
    const u16* Kb = K + (size_t)b * NKV * KP; const u16* Vb = V + (size_t)b * NKV * KP;
    const int wv = tid >> 6;
    int srow[NH], kdst[NH], vdst[NH], soff[NH];
#pragma unroll
    for (int i = 0; i < NH; ++i) {
        const int row = SWA ? (32 * i + 4 * wv + (lane >> 4)) : (8 * wv + (lane >> 3));
        const int c16 = SWA ? (lane & 15) : (lane & 7), hd = SWA ? (c16 >> 3) : 0, c = c16 & 7;
        srow[i] = row; soff[i] = c16 * 8;
        kdst[i] = hd * 8192 + c * 1024 + row * 16;
        vdst[i] = hd * 8192 + ((c >> 2) * 4 + (row >> 4)) * 1024 + (row & 15) * 64 + (c & 3) * 16;
    }
    ALAS const unsigned* maskw = (ALAS const unsigned*)(lds + L_MASK) + r32 * MASK_W;
    ALAS float* wsf = (ALAS float*)(lds + L_WSF) + wid * 64;
    u32x4 kreg[NH], vreg[NH];
#define ATT_LOAD(j) do { _Pragma("unroll") for (int i = 0; i < NH; ++i) { \
        kreg[i] = *(const u32x4*)(Kb + (size_t)(64 * (j) + srow[i]) * KP + soff[i]); \
        vreg[i] = *(const u32x4*)(Vb + (size_t)(64 * (j) + srow[i]) * KP + soff[i]); } } while (0)
#define ATT_STORE(buf) do { _Pragma("unroll") for (int i = 0; i < NH; ++i) { \
        *(ALAS u32x4*)(lds + L_KBUF + (buf) * 16384 + kdst[i]) = kreg[i]; \
        *(ALAS u32x4*)(lds + L_VBUF + (buf) * 16384 + vdst[i]) = vreg[i]; } } while (0)
    float m_run = SWA ? sink2 : 0.0f, lsum = (SWA && hi == 0) ? 1.0f : 0.0f;
    f32x16 negm;
#pragma unroll
    for (int r = 0; r < 16; ++r) negm[r] = -m_run;
    f32x16 o[2]; o[0] = f32x16{}; o[1] = f32x16{};
    ATT_LOAD(j_lo); ATT_STORE(0);
    __syncthreads();
    int cur = 0;
    for (int j = j_lo; j <= j_hi; ++j) {
        const bool more = j < j_hi;
        if (more) ATT_LOAD(j + 1);
        f32x16 p0, p1;
        { ALAS const unsigned char* kb = lds + L_KBUF + cur * 16384 + kvh * 8192 + hi * 1024 + r32 * 16;
#pragma unroll
          for (int d0 = 0; d0 < 4; ++d0) { const bf16x8 b0 = *(ALAS const bf16x8*)(kb + d0 * 2048), b1 = *(ALAS const bf16x8*)(kb + d0 * 2048 + 512);
              if (d0 == 0) { p0 = __builtin_amdgcn_mfma_f32_32x32x16_bf16(b0, qr[0], negm, 0, 0, 0); p1 = __builtin_amdgcn_mfma_f32_32x32x16_bf16(b1, qr[0], negm, 0, 0, 0); }
              else { p0 = __builtin_amdgcn_mfma_f32_32x32x16_bf16(b0, qr[d0], p0, 0, 0, 0); p1 = __builtin_amdgcn_mfma_f32_32x32x16_bf16(b1, qr[d0], p1, 0, 0, 0); } } }
        unsigned w0, w1;
        if (SWA) {
            const int los = (sq - 127) > 112 ? (sq - 127) : 112;
            { const int base = 64 * j; const int a = los - base, e = sq - base; const int a2 = a < 0 ? 0 : a, e2 = e > 31 ? 31 : e;
              w0 = (a2 > 31 || e2 < 0 || a2 > e2) ? 0u : ((0xffffffffu >> (31 - e2)) & (0xffffffffu << a2)); }
            { const int base = 64 * j + 32; const int a = los - base, e = sq - base; const int a2 = a < 0 ? 0 : a, e2 = e > 31 ? 31 : e;
              w1 = (a2 > 31 || e2 < 0 || a2 > e2) ? 0u : ((0xffffffffu >> (31 - e2)) & (0xffffffffu << a2)); }
        } else { const u32x2 ww = *(ALAS const u32x2*)(maskw + 2 * j); w0 = ww.x; w1 = ww.y; }
        w0 >>= 4 * hi; w1 >>= 4 * hi;
        float tm;
        { float a = max3_s(p0[0], p0[1], p1[0]), c = max3_s(p0[2], p0[3], p1[1]); a = max3_s(a, p1[2], p1[3]);
#pragma unroll
          for (int r = 4; r < 16; r += 4) { a = max3_s(a, p0[r], p0[r + 1]); c = max3_s(c, p0[r + 2], p0[r + 3]); a = max3_s(a, p1[r], p1[r + 1]); c = max3_s(c, p1[r + 2], p1[r + 3]); }
          tm = swap_max(max2_s(a, c)); }
        const bool first = (j == j_lo);
        if (first || __any(tm > 8.0f)) {
            const float dl = (first && !SWA) ? tm : max2_s(tm, 0.0f);
            m_run += dl;
#pragma unroll
            for (int r = 0; r < 16; ++r) { p0[r] -= dl; p1[r] -= dl; negm[r] = -m_run; }
            const float alpha = __builtin_amdgcn_exp2f(-dl);
            lsum *= alpha;
            if (!first) {
                if (hi == 0) wsf[r32] = alpha;
                asm volatile("s_waitcnt lgkmcnt(0)" ::: "memory");
#pragma unroll
                for (int r = 0; r < 16; ++r) { const float f = wsf[crow(r, hi)]; o[0][r] *= f; o[1][r] *= f; }
            }
        }
        float sacc = 0.f;
#pragma unroll
        for (int r = 0; r < 16; ++r) {
            const float e0 = __uint_as_float(__float_as_uint(__builtin_amdgcn_exp2f(p0[r])) & bfe1_s(w0, (r & 3) + 8 * (r >> 2)));
            const float e1 = __uint_as_float(__float_as_uint(__builtin_amdgcn_exp2f(p1[r])) & bfe1_s(w1, (r & 3) + 8 * (r >> 2)));
            p0[r] = e0; p1[r] = e1; sacc += e0; sacc += e1; }
        lsum += sacc;
        u32x4 pw0, pw1, pw2, pw3;
#define ATT_PKW(P, B) pg8::cvt_pk_bf16(P[B], P[B + 1])
        pw0 = (u32x4){ATT_PKW(p0, 0), ATT_PKW(p0, 2), ATT_PKW(p0, 4), ATT_PKW(p0, 6)}; pw1 = (u32x4){ATT_PKW(p0, 8), ATT_PKW(p0, 10), ATT_PKW(p0, 12), ATT_PKW(p0, 14)};
        pw2 = (u32x4){ATT_PKW(p1, 0), ATT_PKW(p1, 2), ATT_PKW(p1, 4), ATT_PKW(p1, 6)}; pw3 = (u32x4){ATT_PKW(p1, 8), ATT_PKW(p1, 10), ATT_PKW(p1, 12), ATT_PKW(p1, 14)};
#undef ATT_PKW
        const int vb = (int)(size_t)(lds + L_VBUF + cur * 16384 + kvh * 8192) + ((lane >> 4) & 1) * 32 + (lane & 3) * 8 + (4 * hi + ((lane & 15) >> 2)) * 64;
        pv(o, vb, __builtin_bit_cast(bf16x8, pw0), __builtin_bit_cast(bf16x8, pw1), __builtin_bit_cast(bf16x8, pw2), __builtin_bit_cast(bf16x8, pw3));
        if (more) ATT_STORE(cur ^ 1);
        __syncthreads();
        cur ^= 1;
    }
#undef ATT_LOAD
#undef ATT_STORE
    lsum = swap_add(lsum);
    if (hi == 0) wsf[32 + r32] = lsum;
    asm volatile("s_waitcnt lgkmcnt(0)" ::: "memory");
    ALAS u16* stg = (ALAS u16*)(lds + L_OST + wid * 4096);
#pragma unroll
    for (int r = 0; r < 16; ++r) { const int orow = crow(r, hi); const float rl = __builtin_amdgcn_rcpf(wsf[32 + orow]);
#pragma unroll
        for (int d0 = 0; d0 < 2; ++d0) stg[orow * 64 + d0 * 32 + r32] = (u16)(pg8::cvt_pk_bf16(o[d0][r] * rl, 0.f) & 0xffffu); }
    asm volatile("s_waitcnt lgkmcnt(0)" ::: "memory");
#pragma unroll
    for (int i = 0; i < 4; ++i) { const int row = i * 8 + (lane >> 3), ch = lane & 7; const u32x4 v = *(ALAS const u32x4*)(stg + row * 64 + ch * 8);
        *(u32x4*)(O + (row0 + row) * 512 + wid * 64 + ch * 8) = v; }
    asm volatile("s_waitcnt lgkmcnt(0)" ::: "memory");
}
}

constexpr int NWAVES = 8;
constexpr int N_LAUNCHES = MK_N_LAUNCHES;
constexpr int PER_PHASE = 10;

constexpr size_t MiB = 1u << 20;
constexpr size_t WS_CTL = 0, CTL_ZERO_BYTES = 1 * MiB;
constexpr size_t WS_W1T = 1 * MiB, WS_WD1T = 12 * MiB, WS_WINT = 18 * MiB, WS_WBST = 26 * MiB, WS_WBWT = 27 * MiB, WS_WOUTT = 28 * MiB, WS_W2T = 30 * MiB, WS_WD2T = 41 * MiB;
constexpr size_t WS_COS = 47 * MiB, WS_SIN = 48 * MiB;
constexpr size_t WS_SSQ0 = 49 * MiB, WS_SSQ1 = 51 * MiB, WS_SSQ2 = 53 * MiB, WS_SSQ3 = 55 * MiB;
constexpr size_t WS_WI = 57 * MiB, WS_KA = 58 * MiB, WS_VA = 63 * MiB, WS_KI = 68 * MiB, WS_KS = 73 * MiB, WS_VS = 82 * MiB;
constexpr size_t WS_AM = 91 * MiB, WS_SSQM0 = 91 * MiB + 512 * 1024, WS_SSQM1 = 91 * MiB + 768 * 1024, WS_HM = 92 * MiB, WS_XBM = 93 * MiB + 512 * 1024, WS_H0M = 94 * MiB, WS_H1M = 95 * MiB;
constexpr size_t WS_XB = 96 * MiB;
constexpr size_t WS_HFF = 160 * MiB;
constexpr size_t WS_QA = 160 * MiB, WS_QS = 192 * MiB, WS_QI = 224 * MiB, WS_OSP = 240 * MiB, WS_OSW = 272 * MiB, WS_MERGED = 160 * MiB;
constexpr size_t WS_SGA = 336 * MiB, WS_SGB = 400 * MiB, WS_END = 464 * MiB;
constexpr int CW_ERR = 0;
constexpr int CW_BAR = 4096;

constexpr int RING_OFF = 0, RING_BYTES = 131072;
constexpr int LDSCTL_OFF = 155136, MISC_OFF = LDSCTL_OFF + 320;
constexpr int LDS_BYTES = 155648;
static_assert(att::L_END <= LDSCTL_OFF && MISC_OFF + 128 <= LDS_BYTES, "LDS map");

#define GAS __attribute__((address_space(1)))
#define LAS __attribute__((address_space(3)))
typedef unsigned short bf16;
typedef unsigned v4u __attribute__((ext_vector_type(4)));
typedef float f32x4 __attribute__((ext_vector_type(4)));
typedef GAS unsigned gu32;
#define RLX_AGENT __ATOMIC_RELAXED, __HIP_MEMORY_SCOPE_AGENT
#define LDS_WAIT() asm volatile("s_waitcnt lgkmcnt(0)" ::: "memory")
__device__ __forceinline__ unsigned f2bf(float f) { unsigned u = __builtin_bit_cast(unsigned, f); return (u + 0x7fffu + ((u >> 16) & 1u)) >> 16; }
__device__ __forceinline__ unsigned pk2(float lo, float hi) { return f2bf(lo) | (f2bf(hi) << 16); }
#define XB_TMO      128
#define XB_XCNT(j)  (256  + 64 * (j))
#define XB_XSUB(j)  (1280 + 64 * (j))
#define XB_XGEN(j)  (2304 + 64 * (j))
#define XB_TOP      3328
#define XB_TOPGEN   3392
#define XCD_BAR_WORDS 3456
#define XB_SPIN_CAP (1u << 22)

__device__ __forceinline__ unsigned xb_ld(unsigned* p)              { return __hip_atomic_load(p, __ATOMIC_RELAXED, __HIP_MEMORY_SCOPE_AGENT); }
__device__ __forceinline__ unsigned xb_add(unsigned* p, unsigned v) { return __hip_atomic_fetch_add(p, v, __ATOMIC_RELAXED, __HIP_MEMORY_SCOPE_AGENT); }
__device__ __forceinline__ unsigned xb_xcc_id() { return (unsigned)__builtin_amdgcn_s_getreg((3 << 11) | 20) & 0xFu; }
#define XB_SPIN(cond, bar) do { unsigned _sp = 0; while (cond) { __builtin_amdgcn_s_sleep(1); \
    if ((++_sp & 255u) == 0u) { if (xb_ld(&(bar)[XB_TMO])) break; if (_sp > XB_SPIN_CAP) { atomicAdd(&(bar)[XB_TMO], 1u); break; } } } } while (0)

struct XcdBarrier {
    unsigned* bar; unsigned x;
    volatile LAS unsigned* st;
};

__device__ __forceinline__ XcdBarrier xcd_barrier_post(unsigned* bar, volatile LAS unsigned* st) {
    XcdBarrier b; b.bar = bar; b.x = xb_xcc_id(); b.st = st;
    if (threadIdx.x == 0) (void)xb_add(&bar[XB_XCNT(b.x)], 1u);
    return b;
}
__device__ __forceinline__ void xcd_barrier_complete(unsigned* bar, unsigned x, unsigned& nloc, unsigned& nx) {
    const unsigned G = gridDim.x * gridDim.y * gridDim.z;
    unsigned sum, cnt, mine, sp = 0u;
    for (;;) {
        sum = 0u; cnt = 0u; mine = 0u;
#pragma unroll
        for (unsigned j = 0; j < 16; ++j) { const unsigned c = xb_ld(&bar[XB_XCNT(j)]); sum += c; cnt += (c > 0u) ? 1u : 0u; mine = (j == x) ? c : mine; }
        if (sum == G) break;
        __builtin_amdgcn_s_sleep(1);
        if ((++sp & 255u) == 0u) { if (xb_ld(&bar[XB_TMO])) break; if (sp > XB_SPIN_CAP) { atomicAdd(&bar[XB_TMO], 1u); break; } }
    }
    nloc = mine > 0u ? mine : 1u; nx = cnt > 0u ? cnt : 1u;
}

__device__ __forceinline__ void xcd_barrier(const XcdBarrier& b) {
    asm volatile("s_waitcnt vmcnt(0)" ::: "memory");
    __syncthreads();
    if (threadIdx.x == 0) {
        unsigned* bar = b.bar;
        __builtin_amdgcn_s_waitcnt(0);
        unsigned nloc = b.st[0], nx = b.st[1];
        if (nloc == 0u) { xcd_barrier_complete(bar, b.x, nloc, nx); b.st[0] = nloc; b.st[1] = nx; }
        const unsigned old = xb_add(&bar[XB_XSUB(b.x)], 1u);
        const unsigned gen = old / nloc;
        if (old + 1u == (gen + 1u) * nloc) {
            __builtin_amdgcn_fence(__ATOMIC_RELEASE, "agent");
            asm volatile("s_waitcnt vmcnt(0)" ::: "memory");
            const unsigned og = xb_add(&bar[XB_TOP], 1u);
            const unsigned tg = og / nx;
            if (og + 1u == (tg + 1u) * nx) xb_add(&bar[XB_TOPGEN], 1u);
            else XB_SPIN(xb_ld(&bar[XB_TOPGEN]) == tg, bar);
            __builtin_amdgcn_fence(__ATOMIC_ACQUIRE, "agent");
            xb_add(&bar[XB_XGEN(b.x)], 1u);
            asm volatile("s_waitcnt vmcnt(0)" ::: "memory");
        } else {
            XB_SPIN(xb_ld(&bar[XB_XGEN(b.x)]) == gen, bar);
            __builtin_amdgcn_fence(__ATOMIC_ACQUIRE, "agent");
            asm volatile("s_waitcnt vmcnt(0)" ::: "memory");
        }
    }
    __syncthreads();
}

__device__ __forceinline__ float wave_sum(float v) {
#pragma unroll
    for (int o = 1; o < 64; o <<= 1) v += __shfl_xor(v, o);
    return v;
}
__device__ __forceinline__ int ropepos(int w) { const int i = w & 31, half = w >> 5; return 32 * (i >> 4) + 16 * half + (i & 15); }
struct MapIdent { int off; __device__ __forceinline__ int operator()(int n) const { return off + n; } };
struct MapGateUp { int type; __device__ __forceinline__ int operator()(int j) const { return (j >> 4) * 32 + type * 16 + (j & 15); } };
struct MapInProj { __device__ __forceinline__ int operator()(int n) const {
    if (n < 512) return (n >> 6) * 64 + ropepos(n & 63);
    if (n < 576) return 512 + ropepos(n - 512);
    if (n < 640) return 576 + (n - 576);
    if (n < 896) { const int m = n - 640; return 768 + (m >> 6) * 64 + ropepos(m & 63); }
    if (n < 960) return 640 + ropepos(n - 896);
    if (n < 964) return 704 + (n - 960);
    if (n < 1476) { const int m = n - 964; return 1024 + (m >> 6) * 64 + ropepos(m & 63); }
    if (n < 1604) { const int m = n - 1476; return 1536 + (m >> 6) * 64 + ropepos(m & 63); }
    if (n < 1732) return 1664 + (n - 1604);
    if (n < 2756) return 1792 + (n - 1732);
    return 2816 + (n - 2756);
} };
template <class Map> __device__ __forceinline__ void transpose_item(const float* W, int K, int N, const float* gain, bf16* WT, const Map& map, LAS float* scr, int item, int lane, int ldk = 0, int koff = 0) {
    if (ldk == 0) ldk = K;
    const int nblk = (N + 31) / 32, kb = item / nblk, nb = item % nblk, k0 = 64 * kb, n0 = 32 * nb, n = n0 + (lane & 31);
    float vv[32];
#pragma unroll
    for (int i = 0; i < 32; ++i) { const int kk = 2 * i + (lane >> 5); vv[i] = (n < N) ? W[(size_t)(k0 + kk) * N + n] : 0.f; }
    if (gain) {
#pragma unroll
        for (int i = 0; i < 32; ++i) vv[i] *= gain[k0 + 2 * i + (lane >> 5)]; }
#pragma unroll
    for (int i = 0; i < 32; ++i) scr[(2 * i + (lane >> 5)) * 33 + (lane & 31)] = vv[i];
    LDS_WAIT(); asm volatile("" ::: "memory");
    const int c = lane & 7;
#pragma unroll
    for (int j = 0; j < 4; ++j) { const int nl = (lane >> 3) + 8 * j; if (n0 + nl < N) { const LAS float* s = scr + (8 * c) * 33 + nl;
        v4u o; o.x = pk2(s[0 * 33], s[1 * 33]); o.y = pk2(s[2 * 33], s[3 * 33]); o.z = pk2(s[4 * 33], s[5 * 33]); o.w = pk2(s[6 * 33], s[7 * 33]);
        *(v4u*)(WT + (size_t)map(n0 + nl) * ldk + koff + k0 + 8 * c) = o; } }
    LDS_WAIT(); asm volatile("" ::: "memory");
}
__device__ __forceinline__ void row_to_bf16_ssq(const float* xrow, bf16* orow, float* frow, float* ssqrow, int lane, bool zero) {
    const f32x4* xr = (const f32x4*)xrow + lane; f32x4 v[4]; float s = 0.f;
#pragma unroll
    for (int j = 0; j < 4; ++j) { v[j] = zero ? (f32x4){0.f, 0.f, 0.f, 0.f} : xr[64 * j]; s += (v[j][0] * v[j][0] + v[j][1] * v[j][1]) + (v[j][2] * v[j][2] + v[j][3] * v[j][3]); }
    s = wave_sum(s);
    unsigned long long* o8 = (unsigned long long*)orow + lane;
#pragma unroll
    for (int j = 0; j < 4; ++j) { o8[64 * j] = (unsigned long long)pk2(v[j][0], v[j][1]) | ((unsigned long long)pk2(v[j][2], v[j][3]) << 32); if (frow) ((f32x4*)frow + lane)[64 * j] = v[j]; }
    if (lane < 16) ssqrow[lane] = lane == 0 ? s : 0.f;
}


typedef short mbf16x8 __attribute__((ext_vector_type(8)));
__device__ __forceinline__ void meta_m1(int grp, const bf16* AM, const bf16* W1T, const float* SSQM0, bf16* HM, int lane) {
    const int c = lane & 15, kq = lane >> 4; f32x4 ag = {0.f, 0.f, 0.f, 0.f}, au = {0.f, 0.f, 0.f, 0.f};
    const bf16* ap = AM + (size_t)c * DM + 8 * kq; const bf16* gp = W1T + (size_t)(32 * grp + c) * DM + 8 * kq; const bf16* up = gp + (size_t)16 * DM;
#pragma unroll 8
    for (int kk = 0; kk < DM / 32; ++kk) { const mbf16x8 a = *(const mbf16x8*)(ap + kk * 32), bg = *(const mbf16x8*)(gp + kk * 32), bu = *(const mbf16x8*)(up + kk * 32);
        ag = __builtin_amdgcn_mfma_f32_16x16x32_bf16(a, bg, ag, 0, 0, 0); au = __builtin_amdgcn_mfma_f32_16x16x32_bf16(a, bu, au, 0, 0, 0); }
#pragma unroll
    for (int r = 0; r < 4; ++r) { const int m = 4 * kq + r; const float rs = epi::row_rs(SSQM0, m); const float g = ag[r] * rs, u = au[r] * rs;
        HM[(size_t)m * FF + 16 * grp + c] = (bf16)f2bf(g * epi::sigmoidf_fast(g) * u); }
}
__device__ __forceinline__ void meta_m2(int grp, const bf16* HM, const bf16* WD1T, const float* meta, float* H1M, bf16* XBM, float* SSQM1, int lane) {
    const int c = lane & 15, kq = lane >> 4; f32x4 acc = {0.f, 0.f, 0.f, 0.f};
    const bf16* ap = HM + (size_t)c * FF + 8 * kq; const bf16* bp = WD1T + (size_t)(16 * grp + c) * FF + 8 * kq;
#pragma unroll 8
    for (int kk = 0; kk < FF / 32; ++kk) { const mbf16x8 a = *(const mbf16x8*)(ap + kk * 32), b = *(const mbf16x8*)(bp + kk * 32);
        acc = __builtin_amdgcn_mfma_f32_16x16x32_bf16(a, b, acc, 0, 0, 0); }
#pragma unroll
    for (int r = 0; r < 4; ++r) { const int m = 4 * kq + r, n = 16 * grp + c; const float o = meta[(size_t)m * DM + n] + 0.5f * acc[r];
        H1M[(size_t)m * DM + n] = o; XBM[(size_t)m * DM + n] = (bf16)f2bf(o);
        float q = o * o; q += __shfl_xor(q, 1); q += __shfl_xor(q, 2); q += __shfl_xor(q, 4); q += __shfl_xor(q, 8);
        if (c == 0) SSQM1[m * 64 + grp] = q; }
}
__device__ __forceinline__ void meta_m3(int u, const bf16* XBM, const bf16* WINT, const float* SSQM1, const float* COS, const float* SIN, bf16* KA, bf16* VA, bf16* KI, bf16* KS, bf16* VS, int lane) {
    const int c = lane & 15, kq = lane >> 4; f32x4 a0 = {0.f, 0.f, 0.f, 0.f}, a1 = {0.f, 0.f, 0.f, 0.f};
    const int rowb = (u < 2) ? 512 + 32 * u : (u < 4) ? 576 + 32 * (u - 2) : (u < 6) ? 640 + 32 * (u - 4) : (u < 10) ? 1536 + 32 * (u - 6) : 1664 + 32 * (u - 10);
    const bf16* ap = XBM + (size_t)c * DM + 8 * kq; const bf16* b0 = WINT + (size_t)(rowb + c) * DM + 8 * kq; const bf16* b1 = b0 + (size_t)16 * DM;
#pragma unroll 8
    for (int kk = 0; kk < DM / 32; ++kk) { const mbf16x8 a = *(const mbf16x8*)(ap + kk * 32), x0 = *(const mbf16x8*)(b0 + kk * 32), x1 = *(const mbf16x8*)(b1 + kk * 32);
        a0 = __builtin_amdgcn_mfma_f32_16x16x32_bf16(a, x0, a0, 0, 0, 0); a1 = __builtin_amdgcn_mfma_f32_16x16x32_bf16(a, x1, a1, 0, 0, 0); }
#pragma unroll
    for (int r = 0; r < 4; ++r) { const int m = 4 * kq + r; float s = 0.f;
        for (int i = 0; i < 64; ++i) s += SSQM1[m * 64 + i];
        const float rs = __builtin_amdgcn_rsqf(s * (1.0f / 1024.0f) + EPS); const float v0 = a0[r] * rs, v1 = a1[r] * rs;
        const bool rope = (u < 2) || (u >= 4 && u < 10); const int g = (u < 2) ? u : (u < 6) ? (u - 4) : ((u - 6) & 1), i0 = 16 * g + c;
        float o0 = v0, o1 = v1; if (rope) { const float cs = COS[m * 32 + i0], sn = SIN[m * 32 + i0]; o0 = v0 * cs - v1 * sn; o1 = v1 * cs + v0 * sn; }
        for (int b = 0; b < BATCH; ++b) { const size_t kr = (size_t)b * NKV + 112 + m;
            if (u < 2) { KA[kr * 64 + i0] = (bf16)f2bf(o0); KA[kr * 64 + i0 + 32] = (bf16)f2bf(o1); }
            else if (u < 4) { VA[kr * 64 + 32 * (u - 2) + c] = (bf16)f2bf(o0); VA[kr * 64 + 32 * (u - 2) + 16 + c] = (bf16)f2bf(o1); }
            else if (u < 6) { KI[kr * 64 + i0] = __builtin_bit_cast(unsigned short, (_Float16)o0); KI[kr * 64 + i0 + 32] = __builtin_bit_cast(unsigned short, (_Float16)o1); }
            else if (u < 10) { const int hd = (u - 6) >> 1; KS[kr * 128 + hd * 64 + i0] = (bf16)f2bf(o0); KS[kr * 128 + hd * 64 + i0 + 32] = (bf16)f2bf(o1); }
            else { VS[kr * 128 + 32 * (u - 10) + c] = (bf16)f2bf(o0); VS[kr * 128 + 32 * (u - 10) + 16 + c] = (bf16)f2bf(o1); } }
    }
}

#ifndef PROBE_PHASE
#define PROBE_PHASE -1
#endif
#ifndef PROBE_REPS
#define PROBE_REPS 1
#endif
#define NREP(k) ((k) == PROBE_PHASE ? PROBE_REPS : 1)
#ifndef PROBE_MODE
#define PROBE_MODE 7
#endif
struct Args { const float* in[17]; float* out; unsigned char* ws; int ph_lo, ph_hi, li, mode; };

__global__ void __launch_bounds__(NWAVES * 64, 2) mk_fwd(Args args) {
    extern __shared__ __attribute__((aligned(16))) unsigned char lds_raw[];
    LAS unsigned char* lds = (LAS unsigned char*)lds_raw;
    volatile LAS unsigned* MISC = (volatile LAS unsigned*)(lds + MISC_OFF);
    const int tid = threadIdx.x, lane = tid & 63; const int wave = __builtin_amdgcn_readfirstlane(tid >> 6);
    const int G = gridDim.x; int vcu; { const int bx = blockIdx.x; vcu = (G % 8 == 0) ? (bx % 8) * (G / 8) + bx / 8 : bx; }
    unsigned char* ws = args.ws;
    gu32* ctl = (gu32*)(ws + WS_CTL);
    const float* x = args.in[0];
    bf16 *W1T = (bf16*)(ws + WS_W1T), *WD1T = (bf16*)(ws + WS_WD1T), *WINT = (bf16*)(ws + WS_WINT), *WBST = (bf16*)(ws + WS_WBST), *WBWT = (bf16*)(ws + WS_WBWT),
         *WOUTT = (bf16*)(ws + WS_WOUTT), *W2T = (bf16*)(ws + WS_W2T), *WD2T = (bf16*)(ws + WS_WD2T);
    float *COS = (float*)(ws + WS_COS), *SIN = (float*)(ws + WS_SIN);
    float *SSQ0 = (float*)(ws + WS_SSQ0), *SSQ1 = (float*)(ws + WS_SSQ1), *SSQ2 = (float*)(ws + WS_SSQ2), *SSQ3 = (float*)(ws + WS_SSQ3);
    float* WI = (float*)(ws + WS_WI);
    bf16 *KA = (bf16*)(ws + WS_KA), *VA = (bf16*)(ws + WS_VA), *KI = (bf16*)(ws + WS_KI), *KS = (bf16*)(ws + WS_KS), *VS = (bf16*)(ws + WS_VS);
    bf16 *AM = (bf16*)(ws + WS_AM), *HM = (bf16*)(ws + WS_HM), *XBM = (bf16*)(ws + WS_XBM); float *SSQM0 = (float*)(ws + WS_SSQM0), *SSQM1 = (float*)(ws + WS_SSQM1), *H1M = (float*)(ws + WS_H1M);
    bf16 *XB = (bf16*)(ws + WS_XB), *HFF = (bf16*)(ws + WS_HFF), *QA = (bf16*)(ws + WS_QA), *QS = (bf16*)(ws + WS_QS), *QI = (bf16*)(ws + WS_QI), *OSP = (bf16*)(ws + WS_OSP), *OSW = (bf16*)(ws + WS_OSW),
         *MERGED = (bf16*)(ws + WS_MERGED), *SGA = (bf16*)(ws + WS_SGA), *SGB = (bf16*)(ws + WS_SGB), *T1 = XB;
    float* out = args.out;

    for (int u = tid; u < (LDS_BYTES - LDSCTL_OFF) / 4; u += NWAVES * 64) ((LAS unsigned*)(lds + LDSCTL_OFF))[u] = 0u;
    __syncthreads();
    XcdBarrier bar; bar.bar = (unsigned*)(ctl + CW_BAR); bar.x = 0; bar.st = nullptr;
    if (N_LAUNCHES != PER_PHASE) bar = xcd_barrier_post((unsigned*)(ctl + CW_BAR), MISC + 8);
#define GRID_BAR() do { if (N_LAUNCHES != PER_PHASE) xcd_barrier(bar); } while (0)
    const int lo = args.ph_lo, hi = args.ph_hi;
#define IN(k) (lo <= (k) && (k) < hi)
#define BOTH(k) (IN(k) && IN((k) + 1))
    const int gw = vcu * NWAVES + wave, NGW = G * NWAVES;

    if (IN(0)) {
        LAS float* scr = (LAS float*)(lds + RING_OFF + wave * 16384);
        constexpr int I_GU = 16 * 88, I_D = 44 * 32, I_IN = 16 * 119, I_B = 8 * 32, I_O = 16 * 32;
        constexpr int NITEMS = 4 * I_GU + 2 * I_D + I_IN + 2 * I_B + I_O;
        for (int it = gw; it < NITEMS; it += NGW) {
            int r = it;
            if (r < I_GU) { transpose_item(args.in[3], DM, FF, args.in[2], W1T, MapGateUp{0}, scr, r, lane); continue; } r -= I_GU;
            if (r < I_GU) { transpose_item(args.in[4], DM, FF, args.in[2], W1T, MapGateUp{1}, scr, r, lane); continue; } r -= I_GU;
            if (r < I_GU) { transpose_item(args.in[13], DM, FF, args.in[12], W2T, MapGateUp{0}, scr, r, lane); continue; } r -= I_GU;
            if (r < I_GU) { transpose_item(args.in[14], DM, FF, args.in[12], W2T, MapGateUp{1}, scr, r, lane); continue; } r -= I_GU;
            if (r < I_D) { transpose_item(args.in[5], FF, DM, nullptr, WD1T, MapIdent{0}, scr, r, lane); continue; } r -= I_D;
            if (r < I_D) { transpose_item(args.in[15], FF, DM, nullptr, WD2T, MapIdent{0}, scr, r, lane); continue; } r -= I_D;
            if (r < I_IN) { transpose_item(args.in[7], DM, 3780, args.in[6], WINT, MapInProj{}, scr, r, lane); continue; } r -= I_IN;
            if (r < I_B) { transpose_item(args.in[9], 512, DM, nullptr, WBST, MapIdent{0}, scr, r, lane); continue; } r -= I_B;
            if (r < I_B) { transpose_item(args.in[10], 512, DM, nullptr, WBWT, MapIdent{0}, scr, r, lane); continue; } r -= I_B;
            transpose_item(args.in[11], DM, DM, nullptr, WOUTT, MapIdent{0}, scr, r, lane);
        }
        for (int m = gw; m < MR; m += NGW) row_to_bf16_ssq(x + (size_t)m * DM, XB + (size_t)m * DM, nullptr, SSQ0 + (size_t)m * 16, lane, false);
        for (int m = gw; m < NMETA; m += NGW) row_to_bf16_ssq(args.in[1] + (size_t)m * DM, AM + (size_t)m * DM, nullptr, SSQM0 + (size_t)m * 16, lane, false);
        const int gt = vcu * (NWAVES * 64) + tid, NGT = G * NWAVES * 64;
        for (int i = gt; i < 4112 * 32; i += NGT) { const int pos = i >> 5, fi = i & 31;
            const float e = (float)(2 * fi) / 64.0f, inv = 1.0f / powf(10000.0f, e), ang = (float)pos * inv;
            COS[i] = (float)cos((double)ang); SIN[i] = (float)sin((double)ang); }
        const v4u zero4 = {0u, 0u, 0u, 0u};
        for (int i = gt; i < BATCH * 112 * 56; i += NGT) { const int c = i % 56, rs = i / 56, b = rs / 112, s = rs % 112; const size_t kr = (size_t)b * NKV + s;
            if (c < 8) *(v4u*)(KA + kr * 64 + c * 8) = zero4; else if (c < 16) *(v4u*)(VA + kr * 64 + (c - 8) * 8) = zero4; else if (c < 24) *(v4u*)(KI + kr * 64 + (c - 16) * 8) = zero4;
            else if (c < 40) *(v4u*)(KS + kr * 128 + (c - 24) * 8) = zero4; else *(v4u*)(VS + kr * 128 + (c - 40) * 8) = zero4; }
        for (int i = gt; i < 60 * 128; i += NGT) *(v4u*)(WINT + (size_t)(708 + i / 128) * DM + (i % 128) * 8) = zero4;
        if (BOTH(0)) GRID_BAR();
    }
    if (IN(1)) {
        if (wave == 0 && vcu < 176) meta_m1(vcu, AM, W1T, SSQM0, HM, lane);
        { pg8::Gemm g{XB, W1T, MR, 2 * FF, DM}; pg8::StaticOrder S; S.init(MR, 2 * FF, G, (int)blockIdx.x); epi::EpiGateUp E{HFF, SSQ0};
          pg8::gemm_phase<epi::EpiGateUp, pg8::StaticOrder, true, true>(lds + RING_OFF, g, S, E); }
        if (BOTH(1)) GRID_BAR();
    }
    if (IN(2)) {
        if (wave == 0 && vcu >= 176 && vcu < 240) meta_m2(vcu - 176, HM, WD1T, args.in[1], H1M, XBM, SSQM1, lane);
        { pg8::Gemm g{HFF, WD1T, MR, DM, FF}; pg8::StaticOrder S; S.init(MR, DM, G, (int)blockIdx.x, 1); epi::EpiResid E{x, out, XB, SSQ1, 0.5f};
          pg8::gemm_phase<epi::EpiResid, pg8::StaticOrder, true, true>(lds + RING_OFF, g, S, E); }
        if (BOTH(2)) GRID_BAR();
    }
    if (IN(3)) {
        if (wave == 0 && vcu < 14) meta_m3(vcu, XBM, WINT, SSQM1, COS, SIN, KA, VA, KI, KS, VS, lane);
        { pg8::Gemm g{XB, WINT, MR, NIN, DM}; pg8::StaticOrder S; S.init(MR, NIN, G, (int)blockIdx.x);
          epi::EpiInProj E{SSQ1, COS, SIN, QA, KA, VA, QS, KS, VS, SGA, SGB, QI, KI, WI, 0};
          pg8::gemm_phase<epi::EpiInProj, pg8::StaticOrder, true, true>(lds + RING_OFF, g, S, E); }
        if (BOTH(3)) GRID_BAR();
    }
    if (IN(4)) {
        const float sink2 = args.in[8][wave] * LOG2E;
        for (int i = 0;; ++i) {
            int b, qt;
            if (G == 256) { if (i >= 4) break; const int j = vcu & 31; b = vcu >> 5; qt = (i == 0) ? j : (i == 1) ? 63 - j : (i == 2) ? 64 + j : 127 - j; }
            else { const int u = vcu + i * G; if (u >= BATCH * 128) break; b = u >> 7; qt = u & 127; }
            if (args.mode & 1) att::select_unit(lds, b, qt, QI, KI, WI, (unsigned*)(ctl + CW_ERR), args.mode >> 8);
            if (args.mode & 2) att::attn_unit<false>(lds, b, qt, QA, KA, VA, OSP, 0.f);
            if (args.mode & 4) att::attn_unit<true>(lds, b, qt, QS, KS, VS, OSW, sink2);
            __syncthreads();
        }
        if (BOTH(4)) GRID_BAR();
    }
    if (IN(5)) {
        { pg8::Gemm g{OSP, WBST, MR, DM, 512}; pg8::StaticOrder S; S.init(MR, DM, G, (int)blockIdx.x); epi::EpiBranch<false> E{SGA, T1, MERGED};
          pg8::gemm_phase<epi::EpiBranch<false>, pg8::StaticOrder, true, true>(lds + RING_OFF, g, S, E); }
        { pg8::Gemm g{OSW, WBWT, MR, DM, 512}; pg8::StaticOrder S; S.init(MR, DM, G, (int)blockIdx.x); epi::EpiBranch<true> E{SGB, T1, MERGED};
          pg8::gemm_phase<epi::EpiBranch<true>, pg8::StaticOrder, true, true>(lds + RING_OFF, g, S, E); }
        if (BOTH(5)) GRID_BAR();
    }
    if (IN(6)) {
        pg8::Gemm g{MERGED, WOUTT, MR, DM, DM}; pg8::StaticOrder S; S.init(MR, DM, G, (int)blockIdx.x); epi::EpiResid E{out, out, XB, SSQ2, 1.0f};
        pg8::gemm_phase<epi::EpiResid, pg8::StaticOrder, true, true>(lds + RING_OFF, g, S, E);
        if (BOTH(6)) GRID_BAR();
    }
    if (IN(7)) {
        pg8::Gemm g{XB, W2T, MR, 2 * FF, DM}; pg8::StaticOrder S; S.init(MR, 2 * FF, G, (int)blockIdx.x); epi::EpiGateUp E{HFF, SSQ2};
        pg8::gemm_phase<epi::EpiGateUp, pg8::StaticOrder, true, true>(lds + RING_OFF, g, S, E);
        if (BOTH(7)) GRID_BAR();
    }
    if (IN(8)) {
        pg8::Gemm g{HFF, WD2T, MR, DM, FF}; pg8::StaticOrder S; S.init(MR, DM, G, (int)blockIdx.x, 1); epi::EpiResid E{out, out, nullptr, SSQ3, 0.5f};
        pg8::gemm_phase<epi::EpiResid, pg8::StaticOrder, true, true>(lds + RING_OFF, g, S, E);
        if (BOTH(8)) GRID_BAR();
    }
    if (IN(9)) {
        const bool bad = __hip_atomic_load(ctl + CW_ERR, RLX_AGENT) != 0u || __hip_atomic_load(ctl + CW_BAR + XB_TMO, RLX_AGENT) != 0u;
        const float* gf = args.in[16];
        for (int m = gw; m < MR; m += NGW) {
            const float rs = bad ? __builtin_nanf("") : epi::row_rs(SSQ3, m);
            f32x4* o = (f32x4*)(out + (size_t)m * DM) + lane;
#pragma unroll
            for (int j = 0; j < 4; ++j) { const f32x4 gv = ((const f32x4*)gf + lane)[64 * j]; o[64 * j] = o[64 * j] * rs * gv; }
        }
    }
#undef IN
#undef BOTH
#undef GRID_BAR
}

extern "C" void kernel_launch(void* const* d_in, const int* in_sizes, int n_in, void* d_out, int out_size, void* d_ws, size_t ws_size, hipStream_t stream) {
    static int grid = 0;
    if (grid == 0) {
        if (n_in != 17 || in_sizes[0] != MR * DM || out_size != MR * DM || ws_size < WS_END) {
            fprintf(stderr, "kernel_launch: unexpected shapes (n_in %d, in0 %d, out %d, ws %zu); nothing launched\n", n_in, n_in > 0 ? in_sizes[0] : -1, out_size, ws_size); grid = -1; return; }
        int dev = 0, cus = 0, per_cu = 0;
        if (hipGetDevice(&dev) != hipSuccess || hipDeviceGetAttribute(&cus, hipDeviceAttributeMultiprocessorCount, dev) != hipSuccess) { grid = -1; return; }
        if (hipFuncSetAttribute((const void*)mk_fwd, hipFuncAttributeMaxDynamicSharedMemorySize, LDS_BYTES) != hipSuccess) { fprintf(stderr, "kernel_launch: hipFuncSetAttribute failed\n"); grid = -1; return; }
        if (hipOccupancyMaxActiveBlocksPerMultiprocessor(&per_cu, (const void*)mk_fwd, NWAVES * 64, LDS_BYTES) != hipSuccess || per_cu < 1) {
            fprintf(stderr, "kernel_launch: occupancy query reports %d workgroups per CU; nothing launched\n", per_cu); (void)hipGetLastError(); grid = -1; return; }
        grid = cus;
    }
    if (grid < 0) return;
    if (hipMemsetAsync((char*)d_ws + WS_CTL, 0, CTL_ZERO_BYTES, stream) != hipSuccess) return;
    Args a{};
    for (int i = 0; i < 17; ++i) a.in[i] = (const float*)d_in[i];
    a.out = (float*)d_out; a.ws = (unsigned char*)d_ws; a.mode = 7 | (31 << 8);
    for (int li = 0; li < N_LAUNCHES; ++li) {
        a.ph_lo = (N_LAUNCHES == PER_PHASE) ? li : 0; a.ph_hi = (N_LAUNCHES == PER_PHASE) ? li + 1 : PER_PHASE; a.li = li;
        for (int rep = 0; rep < ((N_LAUNCHES == PER_PHASE) ? NREP(li) : 1); ++rep) { a.mode = (rep == 0) ? (7 | (31 << 8)) : PROBE_MODE; hipLaunchKernelGGL(mk_fwd, dim3(grid), dim3(NWAVES * 64), LDS_BYTES, stream, a); }
        if (hipPeekAtLastError() != hipSuccess) { fprintf(stderr, "kernel_launch: launch %d failed\n", li); break; }
    }
}
```
